# Optimizing an MI355X kernel written in HIP

```python
import jax, jax.numpy as jnp
from jax import lax
import numpy as np

D_MODEL = 1024
BATCH = 16
SEQ = 2048
DEPTH = 1

HEAD_DIM = D_MODEL // 16
N_ATTN_HEADS = 8
N_KV_HEADS = 2
GQA_GROUP = N_ATTN_HEADS // N_KV_HEADS
WINDOW = 128
BLOCK = 128
N_CONV_GROUPS = 4
CONV_WIDTH = N_CONV_GROUPS * HEAD_DIM
CONV_K = 3
N_MEM_HEADS = 4
N_MEM = 256
ATTN_WIDTH = N_ATTN_HEADS * HEAD_DIM
KV_WIDTH = N_KV_HEADS * HEAD_DIM
MEM_WIDTH = N_MEM_HEADS * HEAD_DIM
MIX_WIDTH = ATTN_WIDTH + CONV_WIDTH + MEM_WIDTH
IN_PROJ_WIDTH = ATTN_WIDTH + 2 * KV_WIDTH + 3 * CONV_WIDTH + MEM_WIDTH
SPLIT_POINTS = (
    ATTN_WIDTH,
    ATTN_WIDTH + KV_WIDTH,
    ATTN_WIDTH + 2 * KV_WIDTH,
    ATTN_WIDTH + 2 * KV_WIDTH + CONV_WIDTH,
    ATTN_WIDTH + 2 * KV_WIDTH + 2 * CONV_WIDTH,
    ATTN_WIDTH + 2 * KV_WIDTH + 3 * CONV_WIDTH,
)
D_FF = ((8 * D_MODEL // 3 + 255) // 256) * 256
EPS = 1e-6
NEG_INF = -1e30

kernel_name = "hymba_conv_swa_memory_hybrid"


def rms_norm(x, g):
    xf = x.astype(jnp.float32)
    y = xf * lax.rsqrt(jnp.mean(xf * xf, axis=-1, keepdims=True) + EPS)
    return (y * g.astype(jnp.float32)).astype(x.dtype)


def alibi_slopes():
    return jnp.asarray(2.0 ** (-8.0 * np.arange(1, N_ATTN_HEADS + 1) / N_ATTN_HEADS), dtype=jnp.float32)


def sliding_window_attention(q, k, v, sinks):
    B, S = q.shape[0], q.shape[1]
    nb = S // BLOCK
    qb = q.reshape(B, nb, BLOCK, N_KV_HEADS, GQA_GROUP, HEAD_DIM)

    def band(t):
        tb = t.reshape(B, nb, BLOCK, N_KV_HEADS, HEAD_DIM)
        prev = jnp.pad(tb[:, :-1], ((0, 0), (1, 0), (0, 0), (0, 0), (0, 0)))
        return jnp.concatenate([prev, tb], axis=2)

    kb, vb = band(k), band(v)
    scores = jnp.einsum('bnqhgd,bnkhd->bnhgqk', qb, kb).astype(jnp.float32) * (HEAD_DIM ** -0.5)
    q_idx = jnp.arange(BLOCK)[:, None]
    k_idx = jnp.arange(2 * BLOCK)[None, :]
    dist = q_idx + BLOCK - k_idx
    key_pos = jnp.arange(nb)[:, None] * BLOCK - BLOCK + jnp.arange(2 * BLOCK)[None, :]
    valid = ((dist >= 0) & (dist < WINDOW))[None] & (key_pos >= 0)[:, None, :]
    slopes = alibi_slopes().reshape(N_KV_HEADS, GQA_GROUP)
    bias = -slopes[:, :, None, None] * dist.astype(jnp.float32)
    scores = jnp.where(valid[None, :, None, None], scores + bias[None, None], NEG_INF)
    sink = jnp.broadcast_to(sinks.astype(jnp.float32).reshape(1, 1, N_KV_HEADS, GQA_GROUP, 1, 1),
                            scores.shape[:-1] + (1,))
    probs = jax.nn.softmax(jnp.concatenate([scores, sink], axis=-1), axis=-1)[..., :-1]
    out = jnp.einsum('bnhgqk,bnkhd->bnqhgd', probs.astype(v.dtype), vb)
    return out.reshape(B, S, ATTN_WIDTH)


def short_gated_conv(h, b_gate, c_gate, conv_w, conv_b):
    S = h.shape[1]
    u = c_gate * h
    u_pad = jnp.pad(u, ((0, 0), (CONV_K - 1, 0), (0, 0)))
    conv = sum(conv_w[j] * u_pad[:, j:j + S] for j in range(CONV_K)) + conv_b
    return b_gate * conv


def memory_cross_attention(q, mem_n, w_mem_kv, mem_q_norm, mem_k_norm):
    B, S = q.shape[0], q.shape[1]
    q = rms_norm(q.reshape(B, S, N_MEM_HEADS, HEAD_DIM), mem_q_norm)
    kv = mem_n @ w_mem_kv
    k, v = jnp.split(kv, 2, axis=-1)
    k = rms_norm(k.reshape(B, -1, N_MEM_HEADS, HEAD_DIM), mem_k_norm)
    v = v.reshape(B, -1, N_MEM_HEADS, HEAD_DIM)
    scores = jnp.einsum('bshd,bmhd->bhsm', q, k).astype(jnp.float32) * (HEAD_DIM ** -0.5)
    probs = jax.nn.softmax(scores, axis=-1)
    out = jnp.einsum('bhsm,bmhd->bshd', probs.astype(v.dtype), v)
    return out.reshape(B, S, MEM_WIDTH)


def hybrid_mixer(xn, mem_n, w_in, q_norm, k_norm, attn_sinks, conv_w, conv_b, w_mem_kv,
                 mem_q_norm, mem_k_norm, out_norm_attn, out_norm_conv, out_norm_mem, w_out):
    B, S = xn.shape[0], xn.shape[1]
    proj = xn @ w_in
    q_a, k_a, v_a, c_h, c_b, c_c, q_m = jnp.split(proj, SPLIT_POINTS, axis=-1)
    q_a = rms_norm(q_a.reshape(B, S, N_ATTN_HEADS, HEAD_DIM), q_norm)
    k_a = rms_norm(k_a.reshape(B, S, N_KV_HEADS, HEAD_DIM), k_norm)
    v_a = v_a.reshape(B, S, N_KV_HEADS, HEAD_DIM)
    attn_out = sliding_window_attention(q_a, k_a, v_a, attn_sinks)
    conv_out = short_gated_conv(c_h, c_b, c_c, conv_w, conv_b)
    mem_out = memory_cross_attention(q_m, mem_n, w_mem_kv, mem_q_norm, mem_k_norm)
    merged = jnp.concatenate([rms_norm(attn_out, out_norm_attn),
                              rms_norm(conv_out, out_norm_conv),
                              rms_norm(mem_out, out_norm_mem)], axis=-1)
    return merged @ w_out


def swiglu_ffn(xn, w_gate, w_up, w_down):
    return (jax.nn.silu(xn @ w_gate) * (xn @ w_up)) @ w_down


def setup_inputs(seed: int = 0) -> dict:
    key = jax.random.key(seed)
    ks = jax.random.split(key, 24)
    f32 = jnp.float32

    def normal(k, shape, scale):
        return jax.random.normal(k, shape, f32) * scale

    def gain(k, shape):
        return 1.0 + 0.05 * jax.random.normal(k, shape, f32)

    L = DEPTH
    return {
        "x": jax.random.normal(ks[0], (BATCH, SEQ, D_MODEL), f32),
        "mem": jax.random.normal(ks[1], (BATCH, N_MEM, D_MODEL), f32),
        "norm_mix": gain(ks[2], (L, D_MODEL)),
        "w_in": normal(ks[3], (L, D_MODEL, IN_PROJ_WIDTH), D_MODEL ** -0.5),
        "q_norm": gain(ks[4], (L, HEAD_DIM)),
        "k_norm": gain(ks[5], (L, HEAD_DIM)),
        "attn_sinks": normal(ks[6], (L, N_ATTN_HEADS), 0.5),
        "conv_w": normal(ks[7], (L, CONV_K, CONV_WIDTH), CONV_K ** -0.5),
        "conv_b": normal(ks[8], (L, CONV_WIDTH), 0.01),
        "norm_mem": gain(ks[9], (L, D_MODEL)),
        "w_mem_kv": normal(ks[10], (L, D_MODEL, 2 * MEM_WIDTH), D_MODEL ** -0.5),
        "mem_q_norm": gain(ks[11], (L, HEAD_DIM)),
        "mem_k_norm": gain(ks[12], (L, HEAD_DIM)),
        "out_norm_attn": gain(ks[13], (L, ATTN_WIDTH)),
        "out_norm_conv": gain(ks[14], (L, CONV_WIDTH)),
        "out_norm_mem": gain(ks[15], (L, MEM_WIDTH)),
        "w_out": normal(ks[16], (L, MIX_WIDTH, D_MODEL), MIX_WIDTH ** -0.5),
        "norm_ffn": gain(ks[17], (L, D_MODEL)),
        "w_gate": normal(ks[18], (L, D_MODEL, D_FF), D_MODEL ** -0.5),
        "w_up": normal(ks[19], (L, D_MODEL, D_FF), D_MODEL ** -0.5),
        "w_down": normal(ks[20], (L, D_FF, D_MODEL), D_FF ** -0.5),
    }


def reference(x, mem, norm_mix, w_in, q_norm, k_norm, attn_sinks, conv_w, conv_b, norm_mem,
              w_mem_kv, mem_q_norm, mem_k_norm, out_norm_attn, out_norm_conv, out_norm_mem,
              w_out, norm_ffn, w_gate, w_up, w_down):
    for l in range(DEPTH):
        xn = rms_norm(x, norm_mix[l])
        mem_n = rms_norm(mem, norm_mem[l])
        x = x + hybrid_mixer(xn, mem_n, w_in[l], q_norm[l], k_norm[l], attn_sinks[l], conv_w[l],
                             conv_b[l], w_mem_kv[l], mem_q_norm[l], mem_k_norm[l],
                             out_norm_attn[l], out_norm_conv[l], out_norm_mem[l], w_out[l])
        x = x + swiglu_ffn(rms_norm(x, norm_ffn[l]), w_gate[l], w_up[l], w_down[l])
    return x
```

```cpp
#include <hip/hip_runtime.h>
#include <hip/hip_cooperative_groups.h>
#include <cstdio>
#include <cstdint>
namespace cg = cooperative_groups;
#define MK_N_LAUNCHES 1
#define MIXER mixer_fast
namespace pg8 {
#define PG8_LAS __attribute__((address_space(3)))
typedef unsigned short bf16_t;
typedef short bf16x8 __attribute__((ext_vector_type(8)));
typedef float f32x4 __attribute__((ext_vector_type(4)));
typedef unsigned u32x4 __attribute__((ext_vector_type(4)));
constexpr int BM = 256, BK = 64, HALF = 128, HTB = HALF * BK * 2  , STAGE_BYTES = 8 * HTB, NXCD = 8, WGM = 8;

__host__ __device__ __forceinline__ int lds_byte(int r, int c) { const int st = (r >> 4) * 2 + (c >> 5), rr = r & 15, cc = c & 31, ob = rr * 64 + cc * 2; return st * 1024 + (ob ^ (((ob >> 9) & 1) << 5)); }
__host__ __device__ __forceinline__ void stage_rc(int b, int& R, int& C) { const int st = b / 1024, sb = b % 1024, swz = sb ^ (((sb >> 9) & 1) << 5); R = (st >> 1) * 16 + swz / 64; C = (st & 1) * 32 + (swz % 64) / 2; }
__host__ __device__ __forceinline__ int perm32(int rho) { const int n = rho >> 4, i = rho & 15; return 8 * (i >> 2) + 4 * n + (i & 3); }

struct Unit { int pm, pn; };
struct Gemm { const bf16_t* A; const bf16_t* Bt; int M, N, K; int a_tiled; };

struct StaticOrder {
    int nM, nN, nwg, G, c;
    __host__ __device__ void init(int M, int N, int G_, int c_) { nM = M / BM; nN = N / BM; nwg = nM * nN; G = G_; c = c_; }
    __host__ __device__ bool next(int i, Unit& u) const {
        const long L = (long)i * G + c; if (L >= nwg) return false;
        int wgid = (int)L; { const int q = nwg / NXCD, r = nwg % NXCD, xcd = wgid % NXCD, off = wgid / NXCD; wgid = (xcd < r ? xcd * (q + 1) : r * (q + 1) + (xcd - r) * q) + off; }
        const int nig = WGM * nN, gid = wgid / nig, fm = gid * WGM, gsz = (nM - fm) < WGM ? (nM - fm) : WGM;
        u.pm = fm + ((wgid % nig) % gsz); u.pn = (wgid % nig) / gsz; return true;
    }
    __device__ __forceinline__ void a_ready(const Unit&) const {}
    __device__ __forceinline__ void done(const Unit&) const {}
};

struct RevOrder : StaticOrder {
    int nr;
    __host__ __device__ void init(int M, int N, int G_, int c_) { StaticOrder::init(M, N, G_, c_); nr = (nwg % G == 0) ? nwg / G : 0; }
    __host__ __device__ bool next(int i, Unit& u) const { if (nr == 0) return StaticOrder::next(i, u); return i < nr ? StaticOrder::next(nr - 1 - i, u) : false; }
};

__device__ __forceinline__ unsigned cvt_pk_bf16(float lo, float hi) { typedef float f32x2_t __attribute__((ext_vector_type(2))); typedef __bf16 bf16x2_t __attribute__((ext_vector_type(2)));
    const f32x2_t v = {lo, hi}; const bf16x2_t b = __builtin_convertvector(v, bf16x2_t); return __builtin_bit_cast(unsigned, b); }
typedef float f32x2 __attribute__((ext_vector_type(2)));
#ifdef NT_STORE
#define EPI_ST(p, v) __builtin_nontemporal_store((v), (p))
#else
#define EPI_ST(p, v) (*(p) = (v))
#endif
struct EpiStoreBf16 {
    static constexpr bool PERM = true, AFTER_DRAIN = false;
    bf16_t* O; int ldc;
    __device__ __forceinline__ void operator()(const f32x4 (&acc)[2][2][4][2], const Unit& u, int wr, int wc, int fr, int fq) const {
        const int row0 = u.pm * BM + wr * 64 + fr, col0 = u.pn * BM + wc * 32 + 8 * fq;
#pragma unroll
        for (int ai = 0; ai < 2; ++ai)
#pragma unroll
            for (int m = 0; m < 4; ++m) { bf16_t* rowp = O + (size_t)(row0 + ai * HALF + m * 16) * ldc + col0;
#pragma unroll
                for (int bj = 0; bj < 2; ++bj) { const f32x4 v0 = acc[ai][bj][m][0], v1 = acc[ai][bj][m][1];
                    u32x4 w; w.x = cvt_pk_bf16(v0[0], v0[1]); w.y = cvt_pk_bf16(v0[2], v0[3]); w.z = cvt_pk_bf16(v1[0], v1[1]); w.w = cvt_pk_bf16(v1[2], v1[3]);
                    EPI_ST((u32x4*)(rowp + bj * HALF), w); } }
    }
};
struct EpiOutProj {
    static constexpr bool PERM = true, AFTER_DRAIN = false;
    const float* X; bf16_t* X1B; float* slots; int ldc;
    __device__ __forceinline__ void operator()(const f32x4 (&acc)[2][2][4][2], const Unit& u, int wr, int wc, int fr, int fq) const {
        const int row0 = u.pm * BM + wr * 64 + fr, col0 = u.pn * BM + wc * 32 + 8 * fq;
#pragma unroll
        for (int ai = 0; ai < 2; ++ai) {
            f32x4 xv[4][2][2];
#pragma unroll
            for (int m = 0; m < 4; ++m)
#pragma unroll
                for (int bj = 0; bj < 2; ++bj) { const float* p = X + (size_t)(row0 + ai * HALF + m * 16) * ldc + col0 + bj * HALF; xv[m][bj][0] = __builtin_nontemporal_load((const f32x4*)p); xv[m][bj][1] = __builtin_nontemporal_load((const f32x4*)(p + 4)); }
            __builtin_amdgcn_sched_barrier(0);
#pragma unroll
            for (int m = 0; m < 4; ++m) { const int row = row0 + ai * HALF + m * 16; const size_t off = (size_t)row * ldc + col0; float ss = 0.f;
#pragma unroll
                for (int bj = 0; bj < 2; ++bj) {
                    const f32x4 v0 = acc[ai][bj][m][0] + xv[m][bj][0], v1 = acc[ai][bj][m][1] + xv[m][bj][1];
                    u32x4 w; w.x = cvt_pk_bf16(v0[0], v0[1]); w.y = cvt_pk_bf16(v0[2], v0[3]); w.z = cvt_pk_bf16(v1[0], v1[1]); w.w = cvt_pk_bf16(v1[2], v1[3]);
                    EPI_ST((u32x4*)(X1B + off + bj * HALF), w);
                    ss += (v0[0] * v0[0] + v0[1] * v0[1]) + (v0[2] * v0[2] + v0[3] * v0[3]) + (v1[0] * v1[0] + v1[1] * v1[1]) + (v1[2] * v1[2] + v1[3] * v1[3]); }
                ss += __shfl_xor(ss, 16); ss += __shfl_xor(ss, 32);
                if (fq == 0) slots[(size_t)row * 16 + u.pn * 4 + wc] = ss; }
            __builtin_amdgcn_sched_barrier(0);
        }
    }
};
struct EpiSwiGLU {
    static constexpr bool PERM = true, AFTER_DRAIN = false;
    bf16_t* H; int ldh; const float* slots; float inv_d, eps; const PG8_LAS float* tab; int tpm0, tpm1, tpm2, tpm3; bool use_tab;
    __device__ __forceinline__ void operator()(const f32x4 (&acc)[2][2][4][2], const Unit& u, int wr, int wc, int fr, int fq) const {
        const int rl0 = wr * 64 + fr, row0 = u.pm * BM + rl0, col0 = u.pn * HALF + wc * 32 + 8 * fq;
        const int tslot = (u.pm == tpm0) ? 0 : (u.pm == tpm1) ? 256 : (u.pm == tpm2) ? 512 : 768;
#pragma unroll
        for (int ai = 0; ai < 2; ++ai)
#pragma unroll
            for (int m = 0; m < 4; ++m) { const int row = row0 + ai * HALF + m * 16;
                float r;
                if (use_tab) r = tab[tslot + rl0 + ai * HALF + m * 16];
                else { const f32x4* sp = (const f32x4*)(slots + (size_t)row * 16); const f32x4 s0 = sp[0], s1 = sp[1], s2 = sp[2], s3 = sp[3];
                    const f32x4 st = (s0 + s1) + (s2 + s3); r = __builtin_amdgcn_rsqf(((st[0] + st[1]) + (st[2] + st[3])) * inv_d + eps); }
                float hv[8]; const float cr = -1.4426950408889634f * r, iv = __builtin_amdgcn_rcpf(r * r);
#pragma unroll
                for (int n = 0; n < 2; ++n)
#pragma unroll
                    for (int e = 0; e < 4; ++e) { const float g = acc[ai][0][m][n][e], up = acc[ai][1][m][n][e];
                        hv[n * 4 + e] = (g * up) * __builtin_amdgcn_rcpf(__builtin_fmaf(__builtin_amdgcn_exp2f(cr * g), iv, iv)); }
                u32x4 w; w.x = cvt_pk_bf16(hv[0], hv[1]); w.y = cvt_pk_bf16(hv[2], hv[3]); w.z = cvt_pk_bf16(hv[4], hv[5]); w.w = cvt_pk_bf16(hv[6], hv[7]);
                EPI_ST((u32x4*)(H + (((size_t)u.pm * (ldh / 64) + (col0 >> 6)) * 256 + (rl0 + ai * HALF + m * 16)) * 64 + (col0 & 63)), w); }
    }
};
struct EpiDown {
    static constexpr bool PERM = false, AFTER_DRAIN = false;
    const bf16_t* X1B; float* OUT; int ldc;
    __device__ __forceinline__ void operator()(const f32x4 (&acc)[2][2][4][2], const Unit& u, int wr, int wc, int fr, int fq) const {
        typedef unsigned u32x2 __attribute__((ext_vector_type(2)));
        const int row0 = u.pm * BM + wr * 64 + fr, col0 = u.pn * BM + wc * 32 + 4 * fq;
        u32x2 xv[2][4][2][2];
#pragma unroll
        for (int ai = 0; ai < 2; ++ai)
#pragma unroll
            for (int m = 0; m < 4; ++m)
#pragma unroll
                for (int bj = 0; bj < 2; ++bj)
#pragma unroll
                    for (int n = 0; n < 2; ++n) xv[ai][m][bj][n] = __builtin_nontemporal_load((const u32x2*)(X1B + (size_t)(row0 + ai * HALF + m * 16) * ldc + col0 + bj * HALF + n * 16));
        __builtin_amdgcn_sched_barrier(0);
#pragma unroll
        for (int ai = 0; ai < 2; ++ai)
#pragma unroll
            for (int m = 0; m < 4; ++m) { const size_t off = (size_t)(row0 + ai * HALF + m * 16) * ldc + col0;
#pragma unroll
                for (int bj = 0; bj < 2; ++bj)
#pragma unroll
                    for (int n = 0; n < 2; ++n) { const u32x2 w = xv[ai][m][bj][n];
                        const f32x4 a0 = {__builtin_bit_cast(float, w.x << 16), __builtin_bit_cast(float, w.x & 0xffff0000u), __builtin_bit_cast(float, w.y << 16), __builtin_bit_cast(float, w.y & 0xffff0000u)};
                        EPI_ST((f32x4*)(OUT + off + bj * HALF + n * 16), acc[ai][bj][m][n] + a0); } }
    }
};
template <class Epi, class Sched, bool ALIGN_EPI = false, bool SP2 = false, bool A_NT = false>
__device__ __forceinline__ void gemm_phase(PG8_LAS unsigned char* lds, const Gemm g, const Sched& S, const Epi& E) {
    const int tid = threadIdx.x, wid = __builtin_amdgcn_readfirstlane(tid >> 6), lane = tid & 63, wr = wid >> 2, wc = wid & 3, fr = lane & 15, fq = lane >> 4;
    const int K = g.K, nt = K / BK;
    const bool AT = g.a_tiled != 0;
    unsigned voffA[2], voffB[2];
#pragma unroll
    for (int i = 0; i < 2; ++i) { int R, C; stage_rc(tid * 16 + i * 8192, R, C); const int Rb = Epi::PERM ? ((R & ~31) + perm32(R & 31)) : R;
        voffA[i] = (unsigned)(R * (AT ? BK : K) + C) * 2u; voffB[i] = (unsigned)(Rb * K + C) * 2u; }
    const size_t kstepB = (size_t)(BK * 2), kstepA = AT ? (size_t)(BM * BK * 2) : kstepB;
    const size_t hstepB = (size_t)HALF * K * 2, hstepA = AT ? (size_t)(HALF * BK * 2) : hstepB;
    const size_t tstep = 2 * hstepB;
    const unsigned ldsw = (unsigned)wid * 1024u;
    const int aoff = lds_byte(wr * 64 + fr, fq * 8), boff = lds_byte(wc * 32 + fr, fq * 8);
#define PG8_SA(b, h) (((b) * 2 + (h)) * HTB)
#define PG8_SB(b, h) ((4 + (b) * 2 + (h)) * HTB)
#define PG8_STAGE_AUX(bufoff, gbase, voff, aux) do { _Pragma("unroll") for (int _i = 0; _i < 2; ++_i) \
        __builtin_amdgcn_global_load_lds((const unsigned*)((const char*)(gbase) + (voff)[_i]), (PG8_LAS unsigned*)(lds + (bufoff) + ldsw + _i * 8192), 16, 0, aux); } while (0)
#define PG8_STAGE(bufoff, gbase, voff) do { if constexpr (A_NT) { if ((bufoff) < 4 * HTB) PG8_STAGE_AUX(bufoff, gbase, voff, 2); else PG8_STAGE_AUX(bufoff, gbase, voff, 0); } else PG8_STAGE_AUX(bufoff, gbase, voff, 0); } while (0)
#define PG8_LDA(dst, b, h) do { _Pragma("unroll") for (int m = 0; m < 4; ++m) _Pragma("unroll") for (int k = 0; k < 2; ++k) dst[m][k] = *(const PG8_LAS bf16x8*)(lds + PG8_SA(b, h) + aoff + m * 2048 + k * 1024); } while (0)
#define PG8_LDB(dst, b, h) do { _Pragma("unroll") for (int n = 0; n < 2; ++n) _Pragma("unroll") for (int k = 0; k < 2; ++k) dst[n][k] = *(const PG8_LAS bf16x8*)(lds + PG8_SB(b, h) + boff + n * 2048 + k * 1024); } while (0)
#define PG8_MMA(ai, bj, At, Bt) do { __builtin_amdgcn_s_setprio(1); _Pragma("unroll") for (int m = 0; m < 4; ++m) _Pragma("unroll") for (int n = 0; n < 2; ++n) _Pragma("unroll") for (int k = 0; k < 2; ++k) \
        acc[ai][bj][m][n] = __builtin_amdgcn_mfma_f32_16x16x32_bf16(Bt[n][k], At[m][k], acc[ai][bj][m][n], 0, 0, 0); __builtin_amdgcn_s_setprio(0); } while (0)
#define PG8_WAIT_V(n) asm volatile("s_waitcnt vmcnt(" #n ")" ::: "memory")
#define PG8_WAIT_L(n) asm volatile("s_waitcnt lgkmcnt(" #n ")" ::: "memory")
#define PG8_BAR __builtin_amdgcn_s_barrier()
#define PG8_SCHED __builtin_amdgcn_sched_barrier(0)
    Unit cur, nxt; int ui = 0;
    if (!S.next(0, cur)) return;
    f32x4 acc[2][2][4][2];
#pragma unroll
    for (int a = 0; a < 2; ++a)
#pragma unroll
        for (int b = 0; b < 2; ++b)
#pragma unroll
            for (int m = 0; m < 4; ++m)
#pragma unroll
                for (int n = 0; n < 2; ++n) acc[a][b][m][n] = (f32x4){0.f, 0.f, 0.f, 0.f};
    bf16x8 At[4][2], B0[2][2], B1[2][2];
    const char* cA = (const char*)g.A + (size_t)cur.pm * tstep; const char* cB = (const char*)g.Bt + (size_t)cur.pn * tstep;
    S.a_ready(cur);
    if constexpr (SP2) {
        PG8_STAGE(PG8_SB(0, 0), cB, voffB); PG8_STAGE(PG8_SB(0, 1), cB + hstepB, voffB); PG8_STAGE(PG8_SA(0, 0), cA, voffA); PG8_STAGE(PG8_SA(0, 1), cA + hstepA, voffA);
        if (wr == 1) PG8_BAR;
        PG8_WAIT_V(2); PG8_BAR;
        PG8_STAGE(PG8_SB(1, 0), cB + kstepB, voffB); PG8_STAGE(PG8_SA(1, 0), cA + kstepA, voffA); PG8_STAGE(PG8_SB(1, 1), cB + hstepB + kstepB, voffB);
        PG8_WAIT_V(6); PG8_BAR;
    } else {
        PG8_STAGE(PG8_SB(0, 0), cB, voffB); PG8_STAGE(PG8_SA(0, 0), cA, voffA); PG8_STAGE(PG8_SB(0, 1), cB + hstepB, voffB); PG8_STAGE(PG8_SA(0, 1), cA + hstepA, voffA);
        if (wr == 1) PG8_BAR;
        PG8_WAIT_V(4); PG8_BAR;
        PG8_STAGE(PG8_SB(1, 0), cB + kstepB, voffB); PG8_STAGE(PG8_SA(1, 0), cA + kstepA, voffA); PG8_STAGE(PG8_SB(1, 1), cB + hstepB + kstepB, voffB);
        PG8_WAIT_V(6); PG8_BAR;
    }
    for (;;) {
        const bool has_next = S.next(ui + 1, nxt);
        const char* nA = has_next ? (const char*)g.A + (size_t)nxt.pm * tstep : cA; const char* nB = has_next ? (const char*)g.Bt + (size_t)nxt.pn * tstep : cB;
        for (int t = 0; t < nt; t += 2) {
            const bool last = (t == nt - 2);
            const char* a1 = cA + (size_t)(t + 1) * kstepA;
            const char* a2 = last ? nA : cA + (size_t)(t + 2) * kstepA; const char* b2 = last ? nB : cB + (size_t)(t + 2) * kstepB;
            const char* a3 = a2 + kstepA; const char* b3 = b2 + kstepB;
            if (last && has_next) S.a_ready(nxt);
            if constexpr (SP2) {
            PG8_LDB(B0, 0, 0); PG8_LDB(B1, 0, 1); PG8_SCHED; PG8_LDA(At, 0, 0); PG8_STAGE(PG8_SA(1, 1), a1 + hstepA, voffA);
            PG8_WAIT_V(8); PG8_WAIT_L(0); PG8_BAR; PG8_MMA(0, 0, At, B0); PG8_MMA(0, 1, At, B1); PG8_BAR; PG8_SCHED;
            PG8_LDA(At, 0, 1); PG8_STAGE(PG8_SB(0, 0), b2, voffB); PG8_STAGE(PG8_SB(0, 1), b2 + hstepB, voffB); PG8_STAGE(PG8_SA(0, 0), a2, voffA);
            PG8_WAIT_V(8); PG8_WAIT_L(0); PG8_BAR; PG8_MMA(1, 0, At, B0); PG8_MMA(1, 1, At, B1); PG8_BAR; PG8_SCHED;
            PG8_LDB(B0, 1, 0); PG8_LDB(B1, 1, 1); PG8_SCHED; PG8_LDA(At, 1, 0); PG8_STAGE(PG8_SA(0, 1), a2 + hstepA, voffA);
            PG8_WAIT_V(8); PG8_WAIT_L(0); PG8_BAR; PG8_MMA(0, 0, At, B0); PG8_MMA(0, 1, At, B1); PG8_BAR; PG8_SCHED;
            PG8_LDA(At, 1, 1); PG8_STAGE(PG8_SB(1, 0), b3, voffB); PG8_STAGE(PG8_SB(1, 1), b3 + hstepB, voffB); PG8_STAGE(PG8_SA(1, 0), a3, voffA);
            PG8_WAIT_V(8); PG8_WAIT_L(0); PG8_BAR; PG8_MMA(1, 0, At, B0); PG8_MMA(1, 1, At, B1); PG8_BAR; PG8_SCHED;
            } else {
            PG8_LDB(B0, 0, 0); PG8_SCHED; PG8_LDA(At, 0, 0); PG8_STAGE(PG8_SA(1, 1), a1 + hstepA, voffA);
            PG8_WAIT_L(8); PG8_BAR; PG8_WAIT_L(0); PG8_MMA(0, 0, At, B0); PG8_BAR; PG8_SCHED;
            PG8_LDB(B1, 0, 1); PG8_STAGE(PG8_SB(0, 0), b2, voffB);
            PG8_BAR; PG8_WAIT_L(0); PG8_MMA(0, 1, At, B1); PG8_BAR;
            PG8_LDA(At, 0, 1); PG8_STAGE(PG8_SA(0, 0), a2, voffA);
            PG8_BAR; PG8_WAIT_L(0); PG8_MMA(1, 0, At, B0); PG8_BAR; PG8_SCHED;
            PG8_STAGE(PG8_SB(0, 1), b2 + hstepB, voffB);
            PG8_WAIT_V(6); PG8_BAR; PG8_MMA(1, 1, At, B1); PG8_BAR;
            PG8_LDB(B0, 1, 0); PG8_SCHED; PG8_LDA(At, 1, 0); PG8_STAGE(PG8_SA(0, 1), a2 + hstepA, voffA);
            PG8_WAIT_L(8); PG8_BAR; PG8_WAIT_L(0); PG8_MMA(0, 0, At, B0); PG8_BAR; PG8_SCHED;
            PG8_LDB(B1, 1, 1); PG8_STAGE(PG8_SB(1, 0), b3, voffB);
            PG8_BAR; PG8_WAIT_L(0); PG8_MMA(0, 1, At, B1); PG8_BAR;
            PG8_LDA(At, 1, 1); PG8_STAGE(PG8_SA(1, 0), a3, voffA);
            PG8_BAR; PG8_WAIT_L(0); PG8_MMA(1, 0, At, B0); PG8_BAR; PG8_SCHED;
            PG8_STAGE(PG8_SB(1, 1), b3 + hstepB, voffB);
            PG8_WAIT_V(6); PG8_BAR; PG8_MMA(1, 1, At, B1); PG8_BAR;
            }
        }
        if constexpr (ALIGN_EPI) { if (wr == 0) PG8_BAR; }
        if constexpr (!Epi::AFTER_DRAIN) { E(acc, cur, wr, wc, fr, fq); S.done(cur); }
        if (!has_next) break;
#pragma unroll
        for (int a = 0; a < 2; ++a)
#pragma unroll
            for (int b = 0; b < 2; ++b)
#pragma unroll
                for (int m = 0; m < 4; ++m)
#pragma unroll
                    for (int n = 0; n < 2; ++n) acc[a][b][m][n] = (f32x4){0.f, 0.f, 0.f, 0.f};
        cur = nxt; cA = nA; cB = nB; ++ui;
        if constexpr (ALIGN_EPI) { if (wr == 1) PG8_BAR; }
    }
    PG8_WAIT_V(0);
    if constexpr (!ALIGN_EPI) { if (wr == 0) PG8_BAR; }
    PG8_BAR;
    if constexpr (Epi::AFTER_DRAIN) { E.fused(acc, cur, wr, wc, fr, fq, lds, wid, lane); S.done(cur); }
#undef PG8_SA
#undef PG8_SB
#undef PG8_STAGE
#undef PG8_STAGE_AUX
#undef PG8_LDA
#undef PG8_LDB
#undef PG8_MMA
#undef PG8_WAIT_V
#undef PG8_WAIT_L
#undef PG8_BAR
#undef PG8_SCHED
}
}
#ifndef PG8_SP2
#define PG8_SP2 true
#endif
#ifndef PG8_ALIGN
#define PG8_ALIGN true
#endif
#ifndef MK_N_LAUNCHES
#define MK_N_LAUNCHES 1
#endif
constexpr int NB = 16, SEQ = 2048, D = 1024, M = NB * SEQ;
constexpr int NMEM = 256, MM = NB * NMEM;
constexpr int NPROJ = 1792, DFF = 2816, NGU = 2 * DFF, NMKV = 512;
constexpr int C_Q = 0, C_K = 512, C_V = 640, C_CH = 768, C_CB = 1024, C_CC = 1280, C_QM = 1536;
constexpr float EPS = 1e-6f;
constexpr int NWAVES = 8, NPHASE = 6;
constexpr size_t MiB = 1u << 20;
constexpr size_t WS_SLOTS = 0;
constexpr size_t WS_WIN = 2 * MiB, WS_WMKV = 6 * MiB, WS_WOUT = 7 * MiB, WS_WGU = 9 * MiB, WS_WDN = 20 * MiB;
constexpr size_t WS_MEMN = 32 * MiB, WS_MEMKV = 40 * MiB, WS_X1B = 48 * MiB, WS_PROJ = 112 * MiB, WS_XN = 224 * MiB, WS_MERGED = WS_XN, WS_H = 112 * MiB, WS_END = 288 * MiB;
static_assert(WS_WIN + (size_t)NPROJ * D * 2 <= WS_WMKV && WS_WMKV + (size_t)NMKV * D * 2 <= WS_WOUT && WS_WOUT + (size_t)D * D * 2 <= WS_WGU && WS_WGU + (size_t)NGU * D * 2 <= WS_WDN && WS_WDN + (size_t)D * DFF * 2 <= WS_MEMN, "ws weights");
static_assert(WS_MEMN + (size_t)MM * D * 2 <= WS_MEMKV && WS_MEMKV + (size_t)MM * NMKV * 2 <= WS_X1B && WS_X1B + (size_t)M * D * 2 <= WS_PROJ && WS_PROJ + (size_t)M * NPROJ * 2 <= WS_XN && WS_XN + (size_t)M * D * 2 <= WS_END && WS_H + (size_t)M * DFF * 2 <= WS_END, "ws acts");
constexpr size_t WS_CTL = 26 * MiB, CTL_BYTES = 16384;
constexpr int LDS_BYTES = 147456;

#define LAS __attribute__((address_space(3)))
typedef unsigned short bf16;
typedef unsigned v4u __attribute__((ext_vector_type(4)));
typedef unsigned v2u __attribute__((ext_vector_type(2)));
typedef float f32x4 __attribute__((ext_vector_type(4)));
__device__ __forceinline__ unsigned f2bf(float f) { unsigned u = __builtin_bit_cast(unsigned, f); return (u + 0x7fffu + ((u >> 16) & 1u)) >> 16; }
__device__ __forceinline__ unsigned pk2(float lo, float hi) { return f2bf(lo) | (f2bf(hi) << 16); }
__device__ __forceinline__ float bf2f(bf16 v) { return __builtin_bit_cast(float, (unsigned)v << 16); }
__device__ __forceinline__ float bflo(unsigned w) { return __builtin_bit_cast(float, w << 16); }
__device__ __forceinline__ float bfhi(unsigned w) { return __builtin_bit_cast(float, w & 0xffff0000u); }
__device__ __forceinline__ float wave_sum(float v) {
#pragma unroll
    for (int o = 1; o < 64; o <<= 1) v += __shfl_xor(v, o);
    return v;
}
__device__ __forceinline__ float wave_max(float v) {
#pragma unroll
    for (int o = 1; o < 64; o <<= 1) v = fmaxf(v, __shfl_xor(v, o));
    return v;
}

#define XB_TMO      128
#define XB_XCNT(j)  (256  + 64 * (j))
#define XB_XSUB(j)  (1280 + 64 * (j))
#define XB_XGEN(j)  (2304 + 64 * (j))
#define XB_TOP      3328
#define XB_TOPGEN   3392
#define XCD_BAR_WORDS 3456
#define XB_SPIN_CAP (1u << 18)

__device__ __forceinline__ unsigned xb_ld(unsigned* p)              { return __hip_atomic_load(p, __ATOMIC_RELAXED, __HIP_MEMORY_SCOPE_AGENT); }
__device__ __forceinline__ unsigned xb_add(unsigned* p, unsigned v) { return __hip_atomic_fetch_add(p, v, __ATOMIC_RELAXED, __HIP_MEMORY_SCOPE_AGENT); }
__device__ __forceinline__ unsigned xb_xcc_id() { return (unsigned)__builtin_amdgcn_s_getreg((3 << 11) | 20) & 0xFu; }
#define XB_SPIN(cond, bar) do { unsigned _sp = 0; while (cond) { __builtin_amdgcn_s_sleep(1); \
    if ((++_sp & 255u) == 0u) { if (xb_ld(&(bar)[XB_TMO])) break; if (_sp > XB_SPIN_CAP) { atomicAdd(&(bar)[XB_TMO], 1u); break; } } } } while (0)

struct XcdBarrier {
    unsigned* bar; unsigned x;
    volatile LAS unsigned* st;
};

__device__ __forceinline__ XcdBarrier xcd_barrier_post(unsigned* bar, volatile LAS unsigned* st) {
    XcdBarrier b; b.bar = bar; b.x = xb_xcc_id(); b.st = st;
    if (threadIdx.x == 0) (void)xb_add(&bar[XB_XCNT(b.x)], 1u);
    return b;
}
__device__ __forceinline__ void xcd_barrier_complete(unsigned* bar, unsigned x, unsigned& nloc, unsigned& nx) {
    const unsigned G = gridDim.x * gridDim.y * gridDim.z;
    unsigned sum, cnt, mine, sp = 0u;
    for (;;) {
        sum = 0u; cnt = 0u; mine = 0u;
#pragma unroll
        for (unsigned j = 0; j < 16; ++j) { const unsigned c = xb_ld(&bar[XB_XCNT(j)]); sum += c; cnt += (c > 0u) ? 1u : 0u; mine = (j == x) ? c : mine; }
        if (sum == G) break;
        __builtin_amdgcn_s_sleep(1);
        if ((++sp & 255u) == 0u) { if (xb_ld(&bar[XB_TMO])) break; if (sp > XB_SPIN_CAP) { atomicAdd(&bar[XB_TMO], 1u); break; } }
    }
    nloc = mine > 0u ? mine : 1u; nx = cnt > 0u ? cnt : 1u;
}

__device__ __forceinline__ void xcd_barrier(const XcdBarrier& b) {
    asm volatile("s_waitcnt vmcnt(0)" ::: "memory");
    __syncthreads();
    if (threadIdx.x == 0) {
        unsigned* bar = b.bar;
        __builtin_amdgcn_s_waitcnt(0);
        unsigned nloc = b.st[0], nx = b.st[1];
        if (nloc == 0u) { xcd_barrier_complete(bar, b.x, nloc, nx); b.st[0] = nloc; b.st[1] = nx; }
        const unsigned old = xb_add(&bar[XB_XSUB(b.x)], 1u);
        const unsigned gen = old / nloc;
        if (old + 1u == (gen + 1u) * nloc) {
            __builtin_amdgcn_fence(__ATOMIC_RELEASE, "agent");
            asm volatile("s_waitcnt vmcnt(0)" ::: "memory");
            const unsigned og = xb_add(&bar[XB_TOP], 1u);
            const unsigned tg = og / nx;
            if (og + 1u == (tg + 1u) * nx) xb_add(&bar[XB_TOPGEN], 1u);
            else XB_SPIN(xb_ld(&bar[XB_TOPGEN]) == tg, bar);
            __builtin_amdgcn_fence(__ATOMIC_ACQUIRE, "agent");
            xb_add(&bar[XB_XGEN(b.x)], 1u);
            asm volatile("s_waitcnt vmcnt(0)" ::: "memory");
        } else {
            XB_SPIN(xb_ld(&bar[XB_XGEN(b.x)]) == gen, bar);
            __builtin_amdgcn_fence(__ATOMIC_ACQUIRE, "agent");
            asm volatile("s_waitcnt vmcnt(0)" ::: "memory");
        }
    }
    __syncthreads();
}

struct Args { const float* in[21]; float* out; unsigned char* ws; int ph_lo, ph_hi; };
enum { I_X = 0, I_MEM, I_NORM_MIX, I_W_IN, I_Q_NORM, I_K_NORM, I_SINKS, I_CONV_W, I_CONV_B, I_NORM_MEM, I_W_MEM_KV, I_MEM_Q_NORM, I_MEM_K_NORM,
       I_ON_ATTN, I_ON_CONV, I_ON_MEM, I_W_OUT, I_NORM_FFN, I_W_GATE, I_W_UP, I_W_DOWN };

__device__ __forceinline__ void p0_transpose_item(const float* W, int K, int N, bf16* WT, int dst_row0, const float* kscale, LAS float* scr, int k0, int n0, int lane) {
    float v[32];
#pragma unroll
    for (int i = 0; i < 32; ++i) { const int kk = 2 * i + (lane >> 5); v[i] = __builtin_nontemporal_load(W + (size_t)(k0 + kk) * N + n0 + (lane & 31)); }
    if (kscale) {
#pragma unroll
        for (int i = 0; i < 32; ++i) v[i] *= kscale[k0 + 2 * i + (lane >> 5)]; }
#pragma unroll
    for (int i = 0; i < 32; ++i) { const int kk = 2 * i + (lane >> 5); scr[kk * 33 + (lane & 31)] = v[i]; }
    asm volatile("s_waitcnt lgkmcnt(0)" ::: "memory");
    const int c = lane & 7;
#pragma unroll
    for (int j = 0; j < 4; ++j) { const int n = (lane >> 3) + 8 * j; const LAS float* s = scr + (8 * c) * 33 + n;
        v4u o; o.x = pk2(s[0 * 33], s[1 * 33]); o.y = pk2(s[2 * 33], s[3 * 33]); o.z = pk2(s[4 * 33], s[5 * 33]); o.w = pk2(s[6 * 33], s[7 * 33]);
        *(v4u*)(WT + (size_t)(dst_row0 + n) * K + k0 + 8 * c) = o; }
    asm volatile("s_waitcnt lgkmcnt(0)" ::: "memory");
}
constexpr int I_IN = (D / 64) * (NPROJ / 32), I_MK = (D / 64) * (NMKV / 32), I_O = (D / 64) * (D / 32), I_G = (D / 64) * (DFF / 32), I_DN = (DFF / 64) * (D / 32);
constexpr int NITEMS_EARLY = I_IN + I_MK + I_O, NITEMS_LATE = 2 * I_G + I_DN;
__device__ __forceinline__ void p0_weight_item(const Args& a, int it, LAS float* scr, int lane) {
    unsigned char* ws = a.ws; int r = it;
    if (r < I_IN) { const int nb = NPROJ / 32; p0_transpose_item(a.in[I_W_IN], D, NPROJ, (bf16*)(ws + WS_WIN), 32 * (r % nb), nullptr, scr, 64 * (r / nb), 32 * (r % nb), lane); return; } r -= I_IN;
    if (r < I_MK) { const int nb = NMKV / 32; p0_transpose_item(a.in[I_W_MEM_KV], D, NMKV, (bf16*)(ws + WS_WMKV), 32 * (r % nb), nullptr, scr, 64 * (r / nb), 32 * (r % nb), lane); return; } r -= I_MK;
    if (r < I_O) { const int nb = D / 32; const int k0 = 64 * (r / nb);
        const float* ks = k0 < 512 ? a.in[I_ON_ATTN] : (k0 < 768 ? a.in[I_ON_CONV] - 512 : a.in[I_ON_MEM] - 768);
        p0_transpose_item(a.in[I_W_OUT], D, D, (bf16*)(ws + WS_WOUT), 32 * (r % nb), ks, scr, k0, 32 * (r % nb), lane); return; } r -= I_O;
    if (r < 2 * I_G) { const int up = r >= I_G; if (up) r -= I_G; const int nb = DFF / 32, n0 = 32 * (r % nb);
        p0_transpose_item(a.in[up ? I_W_UP : I_W_GATE], D, DFF, (bf16*)(ws + WS_WGU), (n0 / 128) * 256 + up * 128 + (n0 % 128), a.in[I_NORM_FFN], scr, 64 * (r / nb), n0, lane); return; } r -= 2 * I_G;
    { const int nb = D / 32; p0_transpose_item(a.in[I_W_DOWN], DFF, D, (bf16*)(ws + WS_WDN), 32 * (r % nb), nullptr, scr, 64 * (r / nb), 32 * (r % nb), lane); }
}
__device__ __forceinline__ void p0_rows3(const Args& a, int m0, int lane) {
    f32x4 v[3][4]; const float* gp[3]; bf16* op[3];
#pragma unroll
    for (int r = 0; r < 3; ++r) { const int m = m0 + r; const bool isx = m < M;
        const float* src = isx ? a.in[I_X] + (size_t)m * D : a.in[I_MEM] + (size_t)(m - M) * D;
        gp[r] = isx ? a.in[I_NORM_MIX] : a.in[I_NORM_MEM];
        op[r] = isx ? (bf16*)(a.ws + WS_XN) + (size_t)m * D : (bf16*)(a.ws + WS_MEMN) + (size_t)(m - M) * D;
#pragma unroll
        for (int j = 0; j < 4; ++j) v[r][j] = __builtin_nontemporal_load((const f32x4*)src + lane + 64 * j); }
#pragma unroll
    for (int r = 0; r < 3; ++r) { float s = 0.f;
#pragma unroll
        for (int j = 0; j < 4; ++j) s += (v[r][j].x * v[r][j].x + v[r][j].y * v[r][j].y) + (v[r][j].z * v[r][j].z + v[r][j].w * v[r][j].w);
        const float rstd = __builtin_amdgcn_rsqf(wave_sum(s) * (1.f / D) + EPS);
        unsigned long long* o8 = (unsigned long long*)op[r] + lane;
#pragma unroll
        for (int j = 0; j < 4; ++j) { const f32x4 g = ((const f32x4*)gp[r])[lane + 64 * j];
            o8[64 * j] = (unsigned long long)pk2(v[r][j].x * rstd * g.x, v[r][j].y * rstd * g.y) | ((unsigned long long)pk2(v[r][j].z * rstd * g.z, v[r][j].w * rstd * g.w) << 32); } }
}
__device__ __forceinline__ void p0_prologue(const Args& a, LAS unsigned char* lds, int wave, int lane, bool defer_late) {
    LAS float* scr = (LAS float*)(lds + wave * 16384);
    const int gw = blockIdx.x * NWAVES + wave, NGW = gridDim.x * NWAVES;
    const int nitems = defer_late ? NITEMS_EARLY : NITEMS_EARLY + NITEMS_LATE;
    for (int it = gw; it < nitems; it += NGW) p0_weight_item(a, it, scr, lane);
    static_assert((M + MM) % 3 == 0, "rows in threes");
    for (int m0 = 3 * gw; m0 < M + MM; m0 += 3 * NGW) p0_rows3(a, m0, lane);
}
__device__ __forceinline__ void p1_late_weights(const Args& a, LAS unsigned char* lds, int wave, int lane, int wi, int nw) {
    LAS float* scr = (LAS float*)(lds + wave * 16384);
    for (int it = wi * NWAVES + wave; it < NITEMS_LATE; it += nw * NWAVES) p0_weight_item(a, NITEMS_EARLY + it, scr, lane);
}
namespace mx {
typedef short bf16x8 __attribute__((ext_vector_type(8)));
typedef short s16x4 __attribute__((ext_vector_type(4)));
typedef float f32x16 __attribute__((ext_vector_type(16)));
constexpr int KIMG = 0, VIMG = 65536, SSQA = 131072, SSQM = SSQA + 8192;
constexpr float LOG2E = 1.4426950408889634f, NEG = -1e30f;
__device__ __forceinline__ unsigned off_b(unsigned row, unsigned ch) { return 256u * row + 16u * (ch ^ (((row & 3) << 2) | ((row >> 2) & 3))); }
__device__ __forceinline__ void lds_barrier() { asm volatile("s_waitcnt lgkmcnt(0)\n\ts_barrier" ::: "memory"); }
__device__ __forceinline__ int crow(int r, int hi) { return (r & 3) + 8 * (r >> 2) + 4 * hi; }
__device__ __forceinline__ unsigned cvtpk(float lo, float hi) { typedef float f32x2_t __attribute__((ext_vector_type(2))); typedef __bf16 bf16x2_t __attribute__((ext_vector_type(2)));
    const f32x2_t v = {lo, hi}; const bf16x2_t b = __builtin_convertvector(v, bf16x2_t); return __builtin_bit_cast(unsigned, b); }
__device__ __forceinline__ s16x4 vtr(unsigned addr, LAS unsigned char* lds) { typedef short v4i16_t __attribute__((ext_vector_type(4)));
    return __builtin_bit_cast(s16x4, __builtin_amdgcn_ds_read_tr16_b64_v4i16((LAS v4i16_t*)(lds + addr))); }

struct KVRegs { v4u k[8], v[8]; };
__device__ __forceinline__ void issue_kv(KVRegs& R, const bf16* base, long krow0_off, long vrow0_off, int stride, int first_valid, int tid) {
    const bf16* kp = base + krow0_off + (long)(tid >> 4) * stride + (tid & 15) * 8; const bf16* vp = base + vrow0_off + (long)(tid >> 4) * stride + (tid & 15) * 8;
#pragma unroll
    for (int i = 0; i < 8; ++i) { const int row = (tid >> 4) + 32 * i;
        if (row >= first_valid) { R.k[i] = *(const v4u*)(kp + (long)(32 * i) * stride); R.v[i] = *(const v4u*)(vp + (long)(32 * i) * stride); }
        else { R.k[i] = (v4u){0u, 0u, 0u, 0u}; R.v[i] = (v4u){0u, 0u, 0u, 0u}; } }
}
__device__ __forceinline__ void commit_kv(const KVRegs& R, const LAS float* gain  , LAS unsigned char* lds, int tid) {
    const int c7 = (tid & 7) * 8;
    const f32x4 g0 = *(const LAS f32x4*)(gain + c7), g1 = *(const LAS f32x4*)(gain + c7 + 4);
    LAS unsigned char* kdst = lds + KIMG + off_b(tid >> 4, tid & 15);
#pragma unroll
    for (int i = 0; i < 8; ++i) {
        const v4u k = R.k[i];
        float x[8] = {bflo(k.x), bfhi(k.x), bflo(k.y), bfhi(k.y), bflo(k.z), bfhi(k.z), bflo(k.w), bfhi(k.w)};
        float ss = 0.f;
#pragma unroll
        for (int e = 0; e < 8; ++e) ss += x[e] * x[e];
        ss += __shfl_xor(ss, 1); ss += __shfl_xor(ss, 2); ss += __shfl_xor(ss, 4);
        const float rstd = __builtin_amdgcn_rsqf(ss * (1.f / 64) + EPS);
        v4u o; o.x = cvtpk(x[0] * rstd * g0[0], x[1] * rstd * g0[1]); o.y = cvtpk(x[2] * rstd * g0[2], x[3] * rstd * g0[3]);
        o.z = cvtpk(x[4] * rstd * g1[0], x[5] * rstd * g1[1]); o.w = cvtpk(x[6] * rstd * g1[2], x[7] * rstd * g1[3]);
        *(LAS v4u*)(kdst + 8192 * i) = o;
        *(LAS v4u*)(kdst + (VIMG - KIMG) + 8192 * i) = R.v[i]; }
}
struct QRaw { v4u r[4]; };
__device__ __forceinline__ void load_q_raw(QRaw& Q, const bf16* qrow  , int hi) {
#pragma unroll
    for (int d0 = 0; d0 < 4; ++d0) Q.r[d0] = __builtin_nontemporal_load((const v4u*)(qrow + 16 * d0 + 8 * hi));
}
__device__ __forceinline__ void norm_q(bf16x8 (&qf)[4], const QRaw& Q, const LAS float* gain  , float qscale, int hi) {
    float x[4][8]; float ss = 0.f;
#pragma unroll
    for (int d0 = 0; d0 < 4; ++d0) { const v4u k = Q.r[d0];
        x[d0][0] = bflo(k.x); x[d0][1] = bfhi(k.x); x[d0][2] = bflo(k.y); x[d0][3] = bfhi(k.y); x[d0][4] = bflo(k.z); x[d0][5] = bfhi(k.z); x[d0][6] = bflo(k.w); x[d0][7] = bfhi(k.w);
#pragma unroll
        for (int e = 0; e < 8; ++e) ss += x[d0][e] * x[d0][e]; }
    ss += __shfl_xor(ss, 32);
    const float rs = __builtin_amdgcn_rsqf(ss * (1.f / 64) + EPS) * qscale;
#pragma unroll
    for (int d0 = 0; d0 < 4; ++d0) { const f32x4 g0 = *(const LAS f32x4*)(gain + 16 * d0 + 8 * hi), g1 = *(const LAS f32x4*)(gain + 16 * d0 + 8 * hi + 4);
        v4u o; o.x = cvtpk(x[d0][0] * rs * g0[0], x[d0][1] * rs * g0[1]); o.y = cvtpk(x[d0][2] * rs * g0[2], x[d0][3] * rs * g0[3]);
        o.z = cvtpk(x[d0][4] * rs * g1[0], x[d0][5] * rs * g1[1]); o.w = cvtpk(x[d0][6] * rs * g1[2], x[d0][7] * rs * g1[3]);
        qf[d0] = __builtin_bit_cast(bf16x8, o); }
}
struct TileAddr { unsigned kb[4], vb[2][2]; };
__device__ __forceinline__ TileAddr tile_addr(int kvsel, int lane) {
    TileAddr A; const unsigned r32 = lane & 31, hi = lane >> 5, blk = (lane >> 4) & 1, qq = (lane & 15) >> 2, p = lane & 3;
#pragma unroll
    for (int d0 = 0; d0 < 4; ++d0) A.kb[d0] = KIMG + off_b(r32, 8 * kvsel + 2 * d0 + hi);
#pragma unroll
    for (int db = 0; db < 2; ++db)
#pragma unroll
        for (int t8 = 0; t8 < 2; ++t8) A.vb[db][t8] = VIMG + off_b(4 * hi + qq + 8 * t8, 4 * (2 * kvsel + db) + 2 * blk + (p >> 1)) + 8 * (p & 1);
    return A;
}
template <int EDGE, int TOFF>
__device__ __forceinline__ void attn_tile(LAS unsigned char* lds, const TileAddr& A, const bf16x8 (&qf)[4], const f32x16& cinit, float ck, f32x16 (&o)[2], f32x16& lacc, int lane) {
    const int r32 = lane & 31, hi = lane >> 5;
    bf16x8 kf[4]; s16x4 vlo[2][2], vhh[2][2];
#pragma unroll
    for (int d0 = 0; d0 < 4; ++d0) kf[d0] = *(const LAS bf16x8*)(lds + A.kb[d0] + TOFF);
#pragma unroll
    for (int db = 0; db < 2; ++db)
#pragma unroll
        for (int ks = 0; ks < 2; ++ks) { vlo[db][ks] = vtr(A.vb[db][0] + (TOFF + 4096 * ks), lds); vhh[db][ks] = vtr(A.vb[db][1] + (TOFF + 4096 * ks), lds); }
    __builtin_amdgcn_sched_barrier(0);
    f32x16 s;
#pragma unroll
    for (int d0 = 0; d0 < 4; ++d0) { if (d0 == 0) s = __builtin_amdgcn_mfma_f32_32x32x16_bf16(kf[d0], qf[d0], cinit, 0, 0, 0); else s = __builtin_amdgcn_mfma_f32_32x32x16_bf16(kf[d0], qf[d0], s, 0, 0, 0); }
#pragma unroll
    for (int r = 0; r < 16; ++r) { float p = __builtin_amdgcn_exp2f(s[r] + ck);
        if (EDGE == 1) p = (crow(r, hi) > r32) ? p : 0.f;
        if (EDGE == 2) p = (crow(r, hi) <= r32) ? p : 0.f;
        s[r] = p; }
    bf16x8 pa[2];
#pragma unroll
    for (int ks = 0; ks < 2; ++ks) { v4u w; w.x = cvtpk(s[8 * ks], s[8 * ks + 1]); w.y = cvtpk(s[8 * ks + 2], s[8 * ks + 3]); w.z = cvtpk(s[8 * ks + 4], s[8 * ks + 5]); w.w = cvtpk(s[8 * ks + 6], s[8 * ks + 7]);
        pa[ks] = __builtin_bit_cast(bf16x8, w); }
    const bf16x8 ones = {(short)0x3F80, (short)0x3F80, (short)0x3F80, (short)0x3F80, (short)0x3F80, (short)0x3F80, (short)0x3F80, (short)0x3F80};
#pragma unroll
    for (int ks = 0; ks < 2; ++ks) lacc = __builtin_amdgcn_mfma_f32_32x32x16_bf16(ones, pa[ks], lacc, 0, 0, 0);
#pragma unroll
    for (int db = 0; db < 2; ++db)
#pragma unroll
        for (int ks = 0; ks < 2; ++ks) {
            const bf16x8 vf = __builtin_shufflevector(vlo[db][ks], vhh[db][ks], 0, 1, 2, 3, 4, 5, 6, 7);
            o[db] = __builtin_amdgcn_mfma_f32_32x32x16_bf16(vf, pa[ks], o[db], 0, 0, 0); }
}
__device__ __forceinline__ TileAddr tile_addr_add(const TileAddr& A, unsigned off) { TileAddr B;
#pragma unroll
    for (int d0 = 0; d0 < 4; ++d0) B.kb[d0] = A.kb[d0] + off;
#pragma unroll
    for (int db = 0; db < 2; ++db)
#pragma unroll
        for (int t8 = 0; t8 < 2; ++t8) B.vb[db][t8] = A.vb[db][t8] + off;
    return B; }
__device__ __forceinline__ void zero_o(f32x16 (&o)[2]) {
#pragma unroll
    for (int db = 0; db < 2; ++db)
#pragma unroll
        for (int r = 0; r < 16; ++r) o[db][r] = 0.f;
}
__device__ __forceinline__ void store_o(const f32x16 (&o)[2], float scale, bf16* orow  , int hi) {
    bf16* dst = orow + (hi ? 8 : 0);
#pragma unroll
    for (int db = 0; db < 2; ++db)
#pragma unroll
        for (int g = 0; g < 4; g += 2) {
            unsigned ax = cvtpk(o[db][4 * g] * scale, o[db][4 * g + 1] * scale), ay = cvtpk(o[db][4 * g + 2] * scale, o[db][4 * g + 3] * scale);
            unsigned bx = cvtpk(o[db][4 * g + 4] * scale, o[db][4 * g + 5] * scale), by = cvtpk(o[db][4 * g + 6] * scale, o[db][4 * g + 7] * scale);
            { auto r = __builtin_amdgcn_permlane32_swap(ax, bx, false, false); ax = r[0]; bx = r[1]; }
            { auto r = __builtin_amdgcn_permlane32_swap(ay, by, false, false); ay = r[0]; by = r[1]; }
            *(v4u*)(dst + 32 * db + 8 * g) = (v4u){ax, ay, bx, by}; }
}
__device__ __forceinline__ float sumsq_o(const f32x16 (&o)[2]) { float s = 0.f;
#pragma unroll
    for (int db = 0; db < 2; ++db)
#pragma unroll
        for (int r = 0; r < 16; ++r) s += o[db][r] * o[db][r];
    return s; }
}

__device__ __forceinline__ void mixer_fast(const Args& a, LAS unsigned char* lds, int wave, int lane) {
    using namespace mx;
    const int tid = threadIdx.x, r32 = lane & 31, hi = lane >> 5;
    const bf16* PROJ = (const bf16*)(a.ws + WS_PROJ); const bf16* MEMKV = (const bf16*)(a.ws + WS_MEMKV); bf16* MERGED = (bf16*)(a.ws + WS_MERGED);
    LAS float* ssqa = (LAS float*)(lds + SSQA);
    LAS float* ssqm = (LAS float*)(lds + SSQM);
    LAS float* gtab = (LAS float*)(lds + 143360);
    if (wave == 0) gtab[lane] = a.in[I_Q_NORM][lane];
    if (wave == 1) gtab[64 + lane] = a.in[I_K_NORM][lane];
    if (wave == 2) gtab[128 + lane] = a.in[I_MEM_Q_NORM][lane];
    if (wave == 3) gtab[192 + lane] = a.in[I_MEM_K_NORM][lane];
    __syncthreads();
    const float refa = 8.16f * LOG2E * wave_max(fabsf(gtab[lane])) * wave_max(fabsf(gtab[64 + lane]));
    const float refm = 8.16f * LOG2E * wave_max(fabsf(gtab[128 + lane])) * wave_max(fabsf(gtab[192 + lane]));
    const int h = wave, kvsel_a = h >> 2; const float slope2 = exp2f(-(float)(h + 1)) * LOG2E, sink2 = a.in[I_SINKS][h] * LOG2E;
    const float mfix = fmaxf(refa, sink2);
    f32x16 cbias;
#pragma unroll
    for (int r = 0; r < 16; ++r) { cbias[r] = -slope2 * (float)(128 + r32 - crow(r, hi)) - mfix; }
    for (int u0 = blockIdx.x; u0 < NB * (SEQ / 128); u0 += gridDim.x) {
        const int u = (gridDim.x == 256) ? (u0 & 7) * 32 + (u0 >> 3) : u0;
        const int b = u / (SEQ / 128), n = u % (SEQ / 128); const long tok0 = (long)b * SEQ + n * 128;
        KVRegs R;
        lds_barrier();
        issue_kv(R, PROJ, (tok0 - 128) * NPROJ + C_K, (tok0 - 128) * NPROJ + C_V, NPROJ, n > 0 ? 0 : 128, tid);
        commit_kv(R, gtab + 64, lds, tid);
        int r32a = r32; asm volatile("" : "+v"(r32a));
        QRaw QR; load_q_raw(QR, PROJ + (tok0 + r32a) * NPROJ + C_Q + h * 64, hi);
        lds_barrier();
        {
            const bool has_prev = n > 0; int lane_a = lane; asm volatile("" : "+v"(lane_a)); const TileAddr TA = tile_addr(kvsel_a, lane_a);
#pragma unroll 1
            for (int j = 0; j < 4; ++j) {
                bf16x8 qf[4]; norm_q(qf, QR, gtab, 0.125f * LOG2E, hi);
                if (j < 3) load_q_raw(QR, PROJ + (tok0 + 32 * (j + 1) + r32a) * NPROJ + C_Q + h * 64, hi);
                else load_q_raw(QR, PROJ + (tok0 + 32 * (wave >> 1) + r32a) * NPROJ + C_QM + (wave & 1) * 64, hi);
                f32x16 o[2]; zero_o(o); f32x16 lacc;
#pragma unroll
                for (int r = 0; r < 16; ++r) lacc[r] = 0.f;
                const TileAddr TJ = tile_addr_add(TA, 8192u * j);
                if (has_prev || j >= 4) attn_tile<1, 0>(lds, TJ, qf, cbias, 0.f, o, lacc, lane);
                if (has_prev || j >= 3) attn_tile<0, 8192>(lds, TJ, qf, cbias, 32.f * slope2, o, lacc, lane);
                if (has_prev || j >= 2) attn_tile<0, 16384>(lds, TJ, qf, cbias, 64.f * slope2, o, lacc, lane);
                if (has_prev || j >= 1) attn_tile<0, 24576>(lds, TJ, qf, cbias, 96.f * slope2, o, lacc, lane);
                attn_tile<2, 32768>(lds, TJ, qf, cbias, 128.f * slope2, o, lacc, lane);
                const float inv = __builtin_amdgcn_rcpf(lacc[0] + __builtin_amdgcn_exp2f(sink2 - mfix));
#pragma unroll
                for (int db = 0; db < 2; ++db)
#pragma unroll
                    for (int r = 0; r < 16; ++r) o[db][r] *= inv;
                float ss = sumsq_o(o); ss += __shfl_xor(ss, 32);
                if (hi == 0) ssqa[((j & 1) * 128 + 32 * j + r32) * 8 + h] = ss;
                lds_barrier();
                const LAS f32x4* sp = (const LAS f32x4*)(ssqa + ((j & 1) * 128 + 32 * j + r32) * 8); const f32x4 s0 = sp[0], s1 = sp[1];
                const float tot = ((s0[0] + s0[1]) + (s0[2] + s0[3])) + ((s1[0] + s1[1]) + (s1[2] + s1[3]));
                store_o(o, __builtin_amdgcn_rsqf(tot * (1.f / 512) + EPS), MERGED + (tok0 + 32 * j + r32a) * D + h * 64, hi);
            }
        }
        {
            int lane_m = lane; asm volatile("" : "+v"(lane_m));
            const int hs = wave & 1, jq = wave >> 1; const TileAddr TA = tile_addr(hs, lane_m);
            f32x16 om[2][2]; f32x16 cneg;
#pragma unroll
            for (int r = 0; r < 16; ++r) cneg[r] = -refm;
#pragma unroll
            for (int pass = 0; pass < 2; ++pass) {
                lds_barrier();
                issue_kv(R, MEMKV, (long)b * NMEM * NMKV + 128 * pass, (long)b * NMEM * NMKV + 256 + 128 * pass, NMKV, 0, tid);
                commit_kv(R, gtab + 192, lds, tid);
                lds_barrier();
                const int hm = 2 * pass + hs;
                bf16x8 qf[4]; norm_q(qf, QR, gtab + 128, 0.125f * LOG2E, hi);
                if (pass == 0) load_q_raw(QR, PROJ + (tok0 + 32 * jq + r32) * NPROJ + C_QM + (2 + hs) * 64, hi);
                zero_o(om[pass]); f32x16 lacc;
#pragma unroll
                for (int r = 0; r < 16; ++r) lacc[r] = 0.f;
                attn_tile<0, 0>(lds, TA, qf, cneg, 0.f, om[pass], lacc, lane);     attn_tile<0, 8192>(lds, TA, qf, cneg, 0.f, om[pass], lacc, lane);
                attn_tile<0, 16384>(lds, TA, qf, cneg, 0.f, om[pass], lacc, lane); attn_tile<0, 24576>(lds, TA, qf, cneg, 0.f, om[pass], lacc, lane);
                attn_tile<0, 32768>(lds, TA, qf, cneg, 0.f, om[pass], lacc, lane); attn_tile<0, 40960>(lds, TA, qf, cneg, 0.f, om[pass], lacc, lane);
                attn_tile<0, 49152>(lds, TA, qf, cneg, 0.f, om[pass], lacc, lane); attn_tile<0, 57344>(lds, TA, qf, cneg, 0.f, om[pass], lacc, lane);
                const float inv = __builtin_amdgcn_rcpf(lacc[0]);
#pragma unroll
                for (int db = 0; db < 2; ++db)
#pragma unroll
                    for (int r = 0; r < 16; ++r) om[pass][db][r] *= inv;
            }
            float ss = sumsq_o(om[0]) + sumsq_o(om[1]); ss += __shfl_xor(ss, 32);
            if (hi == 0) ssqm[(32 * jq + r32) * 2 + hs] = ss;
            lds_barrier();
            const float tot = ssqm[(32 * jq + r32) * 2] + ssqm[(32 * jq + r32) * 2 + 1];
            const float rstd = __builtin_amdgcn_rsqf(tot * (1.f / 256) + EPS);
#pragma unroll
            for (int pass = 0; pass < 2; ++pass) { const int hm = 2 * pass + hs;
                store_o(om[pass], rstd, MERGED + (tok0 + 32 * jq + r32) * D + 768 + hm * 64, hi); }
        }
        {
            int tid_c = tid; asm volatile("" : "+v"(tid_c));
            const int c8 = (tid_c & 31) * 8, tg = tid_c >> 5;
            float w0[8], w1[8], w2[8], cb[8];
            const float* cw = a.in[I_CONV_W];
#pragma unroll
            for (int e = 0; e < 8; ++e) { w0[e] = cw[c8 + e]; w1[e] = cw[256 + c8 + e]; w2[e] = cw[512 + c8 + e]; cb[e] = a.in[I_CONV_B][c8 + e]; }
            float um2[8], um1[8];
            const int tseq0 = n * 128 + 8 * tg;
#pragma unroll
            for (int k = 0; k < 2; ++k) { float (&dst)[8] = k == 0 ? um2 : um1;
                if (tseq0 - 2 + k >= 0) { const bf16* r = PROJ + (tok0 + 8 * tg - 2 + k) * NPROJ; const v4u hh = __builtin_nontemporal_load((const v4u*)(r + C_CH + c8)), cc = __builtin_nontemporal_load((const v4u*)(r + C_CC + c8));
                    dst[0] = bflo(hh.x) * bflo(cc.x); dst[1] = bfhi(hh.x) * bfhi(cc.x); dst[2] = bflo(hh.y) * bflo(cc.y); dst[3] = bfhi(hh.y) * bfhi(cc.y);
                    dst[4] = bflo(hh.z) * bflo(cc.z); dst[5] = bfhi(hh.z) * bfhi(cc.z); dst[6] = bflo(hh.w) * bflo(cc.w); dst[7] = bfhi(hh.w) * bfhi(cc.w); }
                else {
#pragma unroll
                    for (int e = 0; e < 8; ++e) dst[e] = 0.f; } }
#pragma unroll
            for (int i0 = 0; i0 < 8; i0 += 8) {
                v4u hh4[8], cc4[8], bb4[8];
#pragma unroll
                for (int i = 0; i < 8; ++i) { const bf16* r = PROJ + (tok0 + 8 * tg + i0 + i) * NPROJ; hh4[i] = __builtin_nontemporal_load((const v4u*)(r + C_CH + c8)); cc4[i] = __builtin_nontemporal_load((const v4u*)(r + C_CC + c8)); bb4[i] = __builtin_nontemporal_load((const v4u*)(r + C_CB + c8)); }
#pragma unroll
                for (int i = 0; i < 8; ++i) { const long tok = tok0 + 8 * tg + i0 + i; const v4u hh = hh4[i], cc = cc4[i], bb = bb4[i];
                    float uc[8] = {bflo(hh.x) * bflo(cc.x), bfhi(hh.x) * bfhi(cc.x), bflo(hh.y) * bflo(cc.y), bfhi(hh.y) * bfhi(cc.y), bflo(hh.z) * bflo(cc.z), bfhi(hh.z) * bfhi(cc.z), bflo(hh.w) * bflo(cc.w), bfhi(hh.w) * bfhi(cc.w)};
                    const float bg[8] = {bflo(bb.x), bfhi(bb.x), bflo(bb.y), bfhi(bb.y), bflo(bb.z), bfhi(bb.z), bflo(bb.w), bfhi(bb.w)};
                    float ov[8], ss = 0.f;
#pragma unroll
                    for (int e = 0; e < 8; ++e) { ov[e] = bg[e] * (w0[e] * um2[e] + w1[e] * um1[e] + w2[e] * uc[e] + cb[e]); ss += ov[e] * ov[e]; um2[e] = um1[e]; um1[e] = uc[e]; }
                    ss += __shfl_xor(ss, 1); ss += __shfl_xor(ss, 2); ss += __shfl_xor(ss, 4); ss += __shfl_xor(ss, 8); ss += __shfl_xor(ss, 16);
                    const float rstd = __builtin_amdgcn_rsqf(ss * (1.f / 256) + EPS);
                    v4u w; w.x = cvtpk(ov[0] * rstd, ov[1] * rstd); w.y = cvtpk(ov[2] * rstd, ov[3] * rstd); w.z = cvtpk(ov[4] * rstd, ov[5] * rstd); w.w = cvtpk(ov[6] * rstd, ov[7] * rstd);
                    *(v4u*)(MERGED + tok * D + 512 + c8) = w; }
            }
        }
    }
}
__global__ void __launch_bounds__(NWAVES * 64, 2) fwd_megakernel(Args args) {
    extern __shared__ __attribute__((aligned(16))) unsigned char lds_raw[];
    LAS unsigned char* lds = (LAS unsigned char*)lds_raw;
    cg::grid_group grid = cg::this_grid();
    const int tid = threadIdx.x, lane = tid & 63, wave = __builtin_amdgcn_readfirstlane(tid >> 6);
    const int lo = args.ph_lo, hi = args.ph_hi, G = gridDim.x;
    unsigned char* ws = args.ws;
    volatile LAS unsigned* MISC = (volatile LAS unsigned*)(lds + LDS_BYTES - 256);
    if (tid < 64) MISC[tid] = 0u;
    __syncthreads();
    XcdBarrier bar; bar.bar = (unsigned*)(ws + WS_CTL); bar.x = 0; bar.st = nullptr;
    if (hi - lo > 1) bar = xcd_barrier_post((unsigned*)(ws + WS_CTL), MISC + 8);
    if (hi < 0) grid.sync();
#define IN(k) (lo <= (k) && (k) < hi)
#define SEAM(k) do { if (IN(k) && IN((k) + 1)) xcd_barrier(bar); } while (0)
    const bool defer_late = (G == 256) && (hi - lo > 1);
    if (IN(0)) { p0_prologue(args, lds, wave, lane, defer_late); }
    SEAM(0);
    if (IN(1)) {
        { pg8::Gemm g{(const bf16*)(ws + WS_XN), (const bf16*)(ws + WS_WIN), M, NPROJ, D, 0}; pg8::StaticOrder S; S.init(M, NPROJ, G, (int)blockIdx.x);
          pg8::EpiStoreBf16 E{(bf16*)(ws + WS_PROJ), NPROJ};
          pg8::gemm_phase<pg8::EpiStoreBf16, pg8::StaticOrder, PG8_ALIGN, PG8_SP2>(lds, g, S, E); }
        { pg8::Gemm g{(const bf16*)(ws + WS_MEMN), (const bf16*)(ws + WS_WMKV), MM, NMKV, D, 0}; pg8::StaticOrder S; S.init(MM, NMKV, G, (int)((blockIdx.x + G / 2) % G));
          pg8::EpiStoreBf16 E{(bf16*)(ws + WS_MEMKV), NMKV};
          pg8::gemm_phase<pg8::EpiStoreBf16, pg8::StaticOrder, PG8_ALIGN, PG8_SP2>(lds, g, S, E); }
        if (defer_late && blockIdx.x >= 160) { __syncthreads(); p1_late_weights(args, lds, wave, lane, (int)blockIdx.x - 160, 96); }
    }
    SEAM(1);
    if (IN(2)) { MIXER(args, lds, wave, lane); }
    SEAM(2);
    if (IN(3)) {
        pg8::Gemm g{(const bf16*)(ws + WS_MERGED), (const bf16*)(ws + WS_WOUT), M, D, D, 0}; pg8::StaticOrder S; S.init(M, D, G, (int)blockIdx.x);
        pg8::EpiOutProj E{args.in[I_X], (bf16*)(ws + WS_X1B), (float*)(ws + WS_SLOTS), D};
        pg8::gemm_phase<pg8::EpiOutProj, pg8::StaticOrder, PG8_ALIGN, PG8_SP2>(lds, g, S, E);
    }
    SEAM(3);
    if (IN(4)) {
        pg8::Gemm g{(const bf16*)(ws + WS_X1B), (const bf16*)(ws + WS_WGU), M, NGU, D, 0}; pg8::StaticOrder S; S.init(M, NGU, G, (int)blockIdx.x);
        LAS float* rtab = (LAS float*)(lds + 131072); int tpm[4] = {-1, -1, -1, -1}; int np = 0; bool tab_ok = true;
        { pg8::Unit uu; for (int i = 0; S.next(i, uu); ++i) { if (uu.pm == tpm[0] || uu.pm == tpm[1] || uu.pm == tpm[2] || uu.pm == tpm[3]) continue;
              if (np == 0) tpm[0] = uu.pm; else if (np == 1) tpm[1] = uu.pm; else if (np == 2) tpm[2] = uu.pm; else if (np == 3) tpm[3] = uu.pm; else tab_ok = false; ++np; } }
        if (tab_ok) {
#pragma unroll
            for (int p = 0; p < 4; ++p) if (p < np) { const int row = tid >> 1, half = tid & 1;
                const f32x4* sp = (const f32x4*)((const float*)(ws + WS_SLOTS) + ((size_t)tpm[p] * 256 + row) * 16 + half * 8); const f32x4 s0 = sp[0], s1 = sp[1];
                float ssum = ((s0[0] + s0[1]) + (s0[2] + s0[3])) + ((s1[0] + s1[1]) + (s1[2] + s1[3])); ssum += __shfl_xor(ssum, 1);
                if (half == 0) rtab[p * 256 + row] = __builtin_amdgcn_rsqf(ssum * (1.f / D) + EPS); }
            __syncthreads();
        }
        pg8::EpiSwiGLU E{(bf16*)(ws + WS_H), DFF, (const float*)(ws + WS_SLOTS), 1.f / D, EPS, rtab, tpm[0], tpm[1], tpm[2], tpm[3], tab_ok};
        pg8::gemm_phase<pg8::EpiSwiGLU, pg8::StaticOrder, PG8_ALIGN, PG8_SP2>(lds, g, S, E);
    }
    SEAM(4);
    if (IN(5)) {
        pg8::Gemm g{(const bf16*)(ws + WS_H), (const bf16*)(ws + WS_WDN), M, D, DFF, 1}; pg8::RevOrder S; S.init(M, D, G, (int)blockIdx.x);
        pg8::EpiDown E{(const bf16*)(ws + WS_X1B), args.out, D};
        pg8::gemm_phase<pg8::EpiDown, pg8::RevOrder, PG8_ALIGN, PG8_SP2>(lds, g, S, E);
    }
#undef IN
#undef SEAM
}

extern "C" void kernel_launch(void* const* d_in, const int* in_sizes, int n_in, void* d_out, int out_size, void* d_ws, size_t ws_size, hipStream_t stream) {
    static int grid = 0;
    if (grid == 0) {
        if (n_in != 21 || in_sizes[0] != M * D || out_size != M * D || ws_size < WS_END) { fprintf(stderr, "kernel_launch: unexpected shapes (n_in %d, in0 %d, out %d, ws %zu); nothing launched\n", n_in, n_in > 0 ? in_sizes[0] : -1, out_size, ws_size); grid = -1; return; }
        int dev = 0, cus = 0, per_cu = 0;
        if (hipGetDevice(&dev) != hipSuccess || hipDeviceGetAttribute(&cus, hipDeviceAttributeMultiprocessorCount, dev) != hipSuccess) { grid = -1; return; }
        if (hipFuncSetAttribute((const void*)fwd_megakernel, hipFuncAttributeMaxDynamicSharedMemorySize, LDS_BYTES) != hipSuccess) { fprintf(stderr, "kernel_launch: hipFuncSetAttribute failed\n"); grid = -1; return; }
        if (hipOccupancyMaxActiveBlocksPerMultiprocessor(&per_cu, (const void*)fwd_megakernel, NWAVES * 64, LDS_BYTES) != hipSuccess || per_cu < 1) { fprintf(stderr, "kernel_launch: occupancy query says %d\n", per_cu); per_cu = 1; }
        (void)hipGetLastError();
        grid = cus * (per_cu > 1 ? 1 : per_cu);
    }
    if (grid < 0) return;
    if (hipMemsetAsync((unsigned char*)d_ws + WS_CTL, 0, CTL_BYTES, stream) != hipSuccess) { fprintf(stderr, "kernel_launch: memset failed\n"); return; }
    Args a{};
    for (int i = 0; i < 21; ++i) a.in[i] = (const float*)d_in[i];
    a.out = (float*)d_out; a.ws = (unsigned char*)d_ws;
#if MK_N_LAUNCHES == 1
    a.ph_lo = 0; a.ph_hi = NPHASE;
    void* kargs[] = {&a};
    hipError_t e = hipLaunchCooperativeKernel((const void*)fwd_megakernel, dim3(grid), dim3(NWAVES * 64), kargs, LDS_BYTES, stream);
    if (e != hipSuccess) fprintf(stderr, "kernel_launch: cooperative launch failed: %s (grid %d)\n", hipGetErrorString(e), grid);
#else
    for (int p = 0; p < NPHASE; ++p) { a.ph_lo = p; a.ph_hi = p + 1;
        hipLaunchKernelGGL(fwd_megakernel, dim3(grid), dim3(NWAVES * 64), LDS_BYTES, stream, a); }
#endif
}
```

```cpp
#include <hip/hip_runtime.h>
#include <hip/hip_cooperative_groups.h>
#include <cstdio>
#include <cstdint>
namespace cg = cooperative_groups;
#define MK_N_LAUNCHES 1
#define MIXER mixer_fast
namespace pg8 {
#define PG8_LAS __attribute__((address_space(3)))
typedef unsigned short bf16_t;
typedef short bf16x8 __attribute__((ext_vector_type(8)));
typedef float f32x4 __attribute__((ext_vector_type(4)));
typedef unsigned u32x4 __attribute__((ext_vector_type(4)));
constexpr int BM = 256, BK = 64, HALF = 128, HTB = HALF * BK * 2  , STAGE_BYTES = 8 * HTB, NXCD = 8, WGM = 8;

__host__ __device__ __forceinline__ int lds_byte(int r, int c) { const int st = (r >> 4) * 2 + (c >> 5), rr = r & 15, cc = c & 31, ob = rr * 64 + cc * 2; return st * 1024 + (ob ^ (((ob >> 9) & 1) << 5)); }
__host__ __device__ __forceinline__ void stage_rc(int b, int& R, int& C) { const int st = b / 1024, sb = b % 1024, swz = sb ^ (((sb >> 9) & 1) << 5); R = (st >> 1) * 16 + swz / 64; C = (st & 1) * 32 + (swz % 64) / 2; }
__host__ __device__ __forceinline__ int perm32(int rho) { const int n = rho >> 4, i = rho & 15; return 8 * (i >> 2) + 4 * n + (i & 3); }

struct Unit { int pm, pn; };
struct Gemm { const bf16_t* A; const bf16_t* Bt; int M, N, K; int a_tiled; };

struct StaticOrder {
    int nM, nN, nwg, G, c;
    __host__ __device__ void init(int M, int N, int G_, int c_) { nM = M / BM; nN = N / BM; nwg = nM * nN; G = G_; c = c_; }
    __host__ __device__ bool next(int i, Unit& u) const {
        const long L = (long)i * G + c; if (L >= nwg) return false;
        int wgid = (int)L; { const int q = nwg / NXCD, r = nwg % NXCD, xcd = wgid % NXCD, off = wgid / NXCD; wgid = (xcd < r ? xcd * (q + 1) : r * (q + 1) + (xcd - r) * q) + off; }
        const int nig = WGM * nN, gid = wgid / nig, fm = gid * WGM, gsz = (nM - fm) < WGM ? (nM - fm) : WGM;
        u.pm = fm + ((wgid % nig) % gsz); u.pn = (wgid % nig) / gsz; return true;
    }
    __device__ __forceinline__ void a_ready(const Unit&) const {}
    __device__ __forceinline__ void done(const Unit&) const {}
};

struct RevOrder : StaticOrder {
    int nr;
    __host__ __device__ void init(int M, int N, int G_, int c_) { StaticOrder::init(M, N, G_, c_); nr = (nwg % G == 0) ? nwg / G : 0; }
    __host__ __device__ bool next(int i, Unit& u) const { if (nr == 0) return StaticOrder::next(i, u); return i < nr ? StaticOrder::next(nr - 1 - i, u) : false; }
};

__device__ __forceinline__ unsigned cvt_pk_bf16(float lo, float hi) { typedef float f32x2_t __attribute__((ext_vector_type(2))); typedef __bf16 bf16x2_t __attribute__((ext_vector_type(2)));
    const f32x2_t v = {lo, hi}; const bf16x2_t b = __builtin_convertvector(v, bf16x2_t); return __builtin_bit_cast(unsigned, b); }
typedef float f32x2 __attribute__((ext_vector_type(2)));
#ifdef NT_STORE
#define EPI_ST(p, v) __builtin_nontemporal_store((v), (p))
#else
#define EPI_ST(p, v) (*(p) = (v))
#endif
struct EpiStoreBf16 {
    static constexpr bool PERM = true, AFTER_DRAIN = false;
    bf16_t* O; int ldc;
    __device__ __forceinline__ void operator()(const f32x4 (&acc)[2][2][4][2], const Unit& u, int wr, int wc, int fr, int fq) const {
        const int row0 = u.pm * BM + wr * 64 + fr, col0 = u.pn * BM + wc * 32 + 8 * fq;
#pragma unroll
        for (int ai = 0; ai < 2; ++ai)
#pragma unroll
            for (int m = 0; m < 4; ++m) { bf16_t* rowp = O + (size_t)(row0 + ai * HALF + m * 16) * ldc + col0;
#pragma unroll
                for (int bj = 0; bj < 2; ++bj) { const f32x4 v0 = acc[ai][bj][m][0], v1 = acc[ai][bj][m][1];
                    u32x4 w; w.x = cvt_pk_bf16(v0[0], v0[1]); w.y = cvt_pk_bf16(v0[2], v0[3]); w.z = cvt_pk_bf16(v1[0], v1[1]); w.w = cvt_pk_bf16(v1[2], v1[3]);
                    EPI_ST((u32x4*)(rowp + bj * HALF), w); } }
    }
};
struct EpiOutProj {
    static constexpr bool PERM = true, AFTER_DRAIN = false;
    const float* X; bf16_t* X1B; float* slots; int ldc;
    __device__ __forceinline__ void operator()(const f32x4 (&acc)[2][2][4][2], const Unit& u, int wr, int wc, int fr, int fq) const {
        const int row0 = u.pm * BM + wr * 64 + fr, col0 = u.pn * BM + wc * 32 + 8 * fq;
#pragma unroll
        for (int ai = 0; ai < 2; ++ai) {
            f32x4 xv[4][2][2];
#pragma unroll
            for (int m = 0; m < 4; ++m)
#pragma unroll
                for (int bj = 0; bj < 2; ++bj) { const float* p = X + (size_t)(row0 + ai * HALF + m * 16) * ldc + col0 + bj * HALF; xv[m][bj][0] = __builtin_nontemporal_load((const f32x4*)p); xv[m][bj][1] = __builtin_nontemporal_load((const f32x4*)(p + 4)); }
            __builtin_amdgcn_sched_barrier(0);
#pragma unroll
            for (int m = 0; m < 4; ++m) { const int row = row0 + ai * HALF + m * 16; const size_t off = (size_t)row * ldc + col0; float ss = 0.f;
#pragma unroll
                for (int bj = 0; bj < 2; ++bj) {
                    const f32x4 v0 = acc[ai][bj][m][0] + xv[m][bj][0], v1 = acc[ai][bj][m][1] + xv[m][bj][1];
                    u32x4 w; w.x = cvt_pk_bf16(v0[0], v0[1]); w.y = cvt_pk_bf16(v0[2], v0[3]); w.z = cvt_pk_bf16(v1[0], v1[1]); w.w = cvt_pk_bf16(v1[2], v1[3]);
                    EPI_ST((u32x4*)(X1B + off + bj * HALF), w);
                    ss += (v0[0] * v0[0] + v0[1] * v0[1]) + (v0[2] * v0[2] + v0[3] * v0[3]) + (v1[0] * v1[0] + v1[1] * v1[1]) + (v1[2] * v1[2] + v1[3] * v1[3]); }
                ss += __shfl_xor(ss, 16); ss += __shfl_xor(ss, 32);
                if (fq == 0) slots[(size_t)row * 16 + u.pn * 4 + wc] = ss; }
            __builtin_amdgcn_sched_barrier(0);
        }
    }
};
struct EpiSwiGLU {
    static constexpr bool PERM = true, AFTER_DRAIN = false;
    bf16_t* H; int ldh; const float* slots; float inv_d, eps; const PG8_LAS float* tab; int tpm0, tpm1, tpm2, tpm3; bool use_tab;
    __device__ __forceinline__ void operator()(const f32x4 (&acc)[2][2][4][2], const Unit& u, int wr, int wc, int fr, int fq) const {
        const int rl0 = wr * 64 + fr, row0 = u.pm * BM + rl0, col0 = u.pn * HALF + wc * 32 + 8 * fq;
        const int tslot = (u.pm == tpm0) ? 0 : (u.pm == tpm1) ? 256 : (u.pm == tpm2) ? 512 : 768;
#pragma unroll
        for (int ai = 0; ai < 2; ++ai)
#pragma unroll
            for (int m = 0; m < 4; ++m) { const int row = row0 + ai * HALF + m * 16;
                float r;
                if (use_tab) r = tab[tslot + rl0 + ai * HALF + m * 16];
                else { const f32x4* sp = (const f32x4*)(slots + (size_t)row * 16); const f32x4 s0 = sp[0], s1 = sp[1], s2 = sp[2], s3 = sp[3];
                    const f32x4 st = (s0 + s1) + (s2 + s3); r = __builtin_amdgcn_rsqf(((st[0] + st[1]) + (st[2] + st[3])) * inv_d + eps); }
                float hv[8]; const float cr = -1.4426950408889634f * r, iv = __builtin_amdgcn_rcpf(r * r);
#pragma unroll
                for (int n = 0; n < 2; ++n)
#pragma unroll
                    for (int e = 0; e < 4; ++e) { const float g = acc[ai][0][m][n][e], up = acc[ai][1][m][n][e];
                        hv[n * 4 + e] = (g * up) * __builtin_amdgcn_rcpf(__builtin_fmaf(__builtin_amdgcn_exp2f(cr * g), iv, iv)); }
                u32x4 w; w.x = cvt_pk_bf16(hv[0], hv[1]); w.y = cvt_pk_bf16(hv[2], hv[3]); w.z = cvt_pk_bf16(hv[4], hv[5]); w.w = cvt_pk_bf16(hv[6], hv[7]);
                __builtin_nontemporal_store(w, (u32x4*)(H + (((size_t)u.pm * (ldh / 64) + (col0 >> 6)) * 256 + (rl0 + ai * HALF + m * 16)) * 64 + (col0 & 63))); }
    }
};
struct EpiDown {
    static constexpr bool PERM = false, AFTER_DRAIN = false;
    const bf16_t* X1B; float* OUT; int ldc;
    __device__ __forceinline__ void operator()(const f32x4 (&acc)[2][2][4][2], const Unit& u, int wr, int wc, int fr, int fq) const {
        typedef unsigned u32x2 __attribute__((ext_vector_type(2)));
        const int row0 = u.pm * BM + wr * 64 + fr, col0 = u.pn * BM + wc * 32 + 4 * fq;
        u32x2 xv[2][4][2][2];
#pragma unroll
        for (int ai = 0; ai < 2; ++ai)
#pragma unroll
            for (int m = 0; m < 4; ++m)
#pragma unroll
                for (int bj = 0; bj < 2; ++bj)
#pragma unroll
                    for (int n = 0; n < 2; ++n) xv[ai][m][bj][n] = __builtin_nontemporal_load((const u32x2*)(X1B + (size_t)(row0 + ai * HALF + m * 16) * ldc + col0 + bj * HALF + n * 16));
        __builtin_amdgcn_sched_barrier(0);
#pragma unroll
        for (int ai = 0; ai < 2; ++ai)
#pragma unroll
            for (int m = 0; m < 4; ++m) { const size_t off = (size_t)(row0 + ai * HALF + m * 16) * ldc + col0;
#pragma unroll
                for (int bj = 0; bj < 2; ++bj)
#pragma unroll
                    for (int n = 0; n < 2; ++n) { const u32x2 w = xv[ai][m][bj][n];
                        const f32x4 a0 = {__builtin_bit_cast(float, w.x << 16), __builtin_bit_cast(float, w.x & 0xffff0000u), __builtin_bit_cast(float, w.y << 16), __builtin_bit_cast(float, w.y & 0xffff0000u)};
                        EPI_ST((f32x4*)(OUT + off + bj * HALF + n * 16), acc[ai][bj][m][n] + a0); } }
    }
};
template <class Epi, class Sched, bool ALIGN_EPI = false, bool SP2 = false, bool A_NT = false>
__device__ __forceinline__ void gemm_phase(PG8_LAS unsigned char* lds, const Gemm g, const Sched& S, const Epi& E) {
    const int tid = threadIdx.x, wid = __builtin_amdgcn_readfirstlane(tid >> 6), lane = tid & 63, wr = wid >> 2, wc = wid & 3, fr = lane & 15, fq = lane >> 4;
    const int K = g.K, nt = K / BK;
    const bool AT = g.a_tiled != 0;
    unsigned voffA[2], voffB[2];
#pragma unroll
    for (int i = 0; i < 2; ++i) { int R, C; stage_rc(tid * 16 + i * 8192, R, C); const int Rb = Epi::PERM ? ((R & ~31) + perm32(R & 31)) : R;
        voffA[i] = (unsigned)(R * (AT ? BK : K) + C) * 2u; voffB[i] = (unsigned)(Rb * K + C) * 2u; }
    const size_t kstepB = (size_t)(BK * 2), kstepA = AT ? (size_t)(BM * BK * 2) : kstepB;
    const size_t hstepB = (size_t)HALF * K * 2, hstepA = AT ? (size_t)(HALF * BK * 2) : hstepB;
    const size_t tstep = 2 * hstepB;
    const unsigned ldsw = (unsigned)wid * 1024u;
    const int aoff = lds_byte(wr * 64 + fr, fq * 8), boff = lds_byte(wc * 32 + fr, fq * 8);
#define PG8_SA(b, h) (((b) * 2 + (h)) * HTB)
#define PG8_SB(b, h) ((4 + (b) * 2 + (h)) * HTB)
#define PG8_STAGE_AUX(bufoff, gbase, voff, aux) do { _Pragma("unroll") for (int _i = 0; _i < 2; ++_i) \
        __builtin_amdgcn_global_load_lds((const unsigned*)((const char*)(gbase) + (voff)[_i]), (PG8_LAS unsigned*)(lds + (bufoff) + ldsw + _i * 8192), 16, 0, aux); } while (0)
#define PG8_STAGE(bufoff, gbase, voff) do { if constexpr (A_NT) { if ((bufoff) < 4 * HTB) PG8_STAGE_AUX(bufoff, gbase, voff, 2); else PG8_STAGE_AUX(bufoff, gbase, voff, 0); } else PG8_STAGE_AUX(bufoff, gbase, voff, 0); } while (0)
#define PG8_LDA(dst, b, h) do { _Pragma("unroll") for (int m = 0; m < 4; ++m) _Pragma("unroll") for (int k = 0; k < 2; ++k) dst[m][k] = *(const PG8_LAS bf16x8*)(lds + PG8_SA(b, h) + aoff + m * 2048 + k * 1024); } while (0)
#define PG8_LDB(dst, b, h) do { _Pragma("unroll") for (int n = 0; n < 2; ++n) _Pragma("unroll") for (int k = 0; k < 2; ++k) dst[n][k] = *(const PG8_LAS bf16x8*)(lds + PG8_SB(b, h) + boff + n * 2048 + k * 1024); } while (0)
#define PG8_MMA(ai, bj, At, Bt) do { __builtin_amdgcn_s_setprio(1); _Pragma("unroll") for (int m = 0; m < 4; ++m) _Pragma("unroll") for (int n = 0; n < 2; ++n) _Pragma("unroll") for (int k = 0; k < 2; ++k) \
        acc[ai][bj][m][n] = __builtin_amdgcn_mfma_f32_16x16x32_bf16(Bt[n][k], At[m][k], acc[ai][bj][m][n], 0, 0, 0); __builtin_amdgcn_s_setprio(0); } while (0)
#define PG8_WAIT_V(n) asm volatile("s_waitcnt vmcnt(" #n ")" ::: "memory")
#define PG8_WAIT_L(n) asm volatile("s_waitcnt lgkmcnt(" #n ")" ::: "memory")
#define PG8_BAR __builtin_amdgcn_s_barrier()
#define PG8_SCHED __builtin_amdgcn_sched_barrier(0)
    Unit cur, nxt; int ui = 0;
    if (!S.next(0, cur)) return;
    f32x4 acc[2][2][4][2];
#pragma unroll
    for (int a = 0; a < 2; ++a)
#pragma unroll
        for (int b = 0; b < 2; ++b)
#pragma unroll
            for (int m = 0; m < 4; ++m)
#pragma unroll
                for (int n = 0; n < 2; ++n) acc[a][b][m][n] = (f32x4){0.f, 0.f, 0.f, 0.f};
    bf16x8 At[4][2], B0[2][2], B1[2][2];
    const char* cA = (const char*)g.A + (size_t)cur.pm * tstep; const char* cB = (const char*)g.Bt + (size_t)cur.pn * tstep;
    S.a_ready(cur);
    if constexpr (SP2) {
        PG8_STAGE(PG8_SB(0, 0), cB, voffB); PG8_STAGE(PG8_SB(0, 1), cB + hstepB, voffB); PG8_STAGE(PG8_SA(0, 0), cA, voffA); PG8_STAGE(PG8_SA(0, 1), cA + hstepA, voffA);
        if (wr == 1) PG8_BAR;
        PG8_WAIT_V(2); PG8_BAR;
        PG8_STAGE(PG8_SB(1, 0), cB + kstepB, voffB); PG8_STAGE(PG8_SA(1, 0), cA + kstepA, voffA); PG8_STAGE(PG8_SB(1, 1), cB + hstepB + kstepB, voffB);
        PG8_WAIT_V(6); PG8_BAR;
    } else {
        PG8_STAGE(PG8_SB(0, 0), cB, voffB); PG8_STAGE(PG8_SA(0, 0), cA, voffA); PG8_STAGE(PG8_SB(0, 1), cB + hstepB, voffB); PG8_STAGE(PG8_SA(0, 1), cA + hstepA, voffA);
        if (wr == 1) PG8_BAR;
        PG8_WAIT_V(4); PG8_BAR;
        PG8_STAGE(PG8_SB(1, 0), cB + kstepB, voffB); PG8_STAGE(PG8_SA(1, 0), cA + kstepA, voffA); PG8_STAGE(PG8_SB(1, 1), cB + hstepB + kstepB, voffB);
        PG8_WAIT_V(6); PG8_BAR;
    }
    for (;;) {
        const bool has_next = S.next(ui + 1, nxt);
        const char* nA = has_next ? (const char*)g.A + (size_t)nxt.pm * tstep : cA; const char* nB = has_next ? (const char*)g.Bt + (size_t)nxt.pn * tstep : cB;
        for (int t = 0; t < nt; t += 2) {
            const bool last = (t == nt - 2);
            const char* a1 = cA + (size_t)(t + 1) * kstepA;
            const char* a2 = last ? nA : cA + (size_t)(t + 2) * kstepA; const char* b2 = last ? nB : cB + (size_t)(t + 2) * kstepB;
            const char* a3 = a2 + kstepA; const char* b3 = b2 + kstepB;
            if (last && has_next) S.a_ready(nxt);
            if constexpr (SP2) {
            PG8_LDB(B0, 0, 0); PG8_LDB(B1, 0, 1); PG8_SCHED; PG8_LDA(At, 0, 0); PG8_STAGE(PG8_SA(1, 1), a1 + hstepA, voffA);
            PG8_WAIT_V(8); PG8_WAIT_L(0); PG8_BAR; PG8_MMA(0, 0, At, B0); PG8_MMA(0, 1, At, B1); PG8_BAR; PG8_SCHED;
            PG8_LDA(At, 0, 1); PG8_STAGE(PG8_SB(0, 0), b2, voffB); PG8_STAGE(PG8_SB(0, 1), b2 + hstepB, voffB); PG8_STAGE(PG8_SA(0, 0), a2, voffA);
            PG8_WAIT_V(8); PG8_WAIT_L(0); PG8_BAR; PG8_MMA(1, 0, At, B0); PG8_MMA(1, 1, At, B1); PG8_BAR; PG8_SCHED;
            PG8_LDB(B0, 1, 0); PG8_LDB(B1, 1, 1); PG8_SCHED; PG8_LDA(At, 1, 0); PG8_STAGE(PG8_SA(0, 1), a2 + hstepA, voffA);
            PG8_WAIT_V(8); PG8_WAIT_L(0); PG8_BAR; PG8_MMA(0, 0, At, B0); PG8_MMA(0, 1, At, B1); PG8_BAR; PG8_SCHED;
            PG8_LDA(At, 1, 1); PG8_STAGE(PG8_SB(1, 0), b3, voffB); PG8_STAGE(PG8_SB(1, 1), b3 + hstepB, voffB); PG8_STAGE(PG8_SA(1, 0), a3, voffA);
            PG8_WAIT_V(8); PG8_WAIT_L(0); PG8_BAR; PG8_MMA(1, 0, At, B0); PG8_MMA(1, 1, At, B1); PG8_BAR; PG8_SCHED;
            } else {
            PG8_LDB(B0, 0, 0); PG8_SCHED; PG8_LDA(At, 0, 0); PG8_STAGE(PG8_SA(1, 1), a1 + hstepA, voffA);
            PG8_WAIT_L(8); PG8_BAR; PG8_WAIT_L(0); PG8_MMA(0, 0, At, B0); PG8_BAR; PG8_SCHED;
            PG8_LDB(B1, 0, 1); PG8_STAGE(PG8_SB(0, 0), b2, voffB);
            PG8_BAR; PG8_WAIT_L(0); PG8_MMA(0, 1, At, B1); PG8_BAR;
            PG8_LDA(At, 0, 1); PG8_STAGE(PG8_SA(0, 0), a2, voffA);
            PG8_BAR; PG8_WAIT_L(0); PG8_MMA(1, 0, At, B0); PG8_BAR; PG8_SCHED;
            PG8_STAGE(PG8_SB(0, 1), b2 + hstepB, voffB);
            PG8_WAIT_V(6); PG8_BAR; PG8_MMA(1, 1, At, B1); PG8_BAR;
            PG8_LDB(B0, 1, 0); PG8_SCHED; PG8_LDA(At, 1, 0); PG8_STAGE(PG8_SA(0, 1), a2 + hstepA, voffA);
            PG8_WAIT_L(8); PG8_BAR; PG8_WAIT_L(0); PG8_MMA(0, 0, At, B0); PG8_BAR; PG8_SCHED;
            PG8_LDB(B1, 1, 1); PG8_STAGE(PG8_SB(1, 0), b3, voffB);
            PG8_BAR; PG8_WAIT_L(0); PG8_MMA(0, 1, At, B1); PG8_BAR;
            PG8_LDA(At, 1, 1); PG8_STAGE(PG8_SA(1, 0), a3, voffA);
            PG8_BAR; PG8_WAIT_L(0); PG8_MMA(1, 0, At, B0); PG8_BAR; PG8_SCHED;
            PG8_STAGE(PG8_SB(1, 1), b3 + hstepB, voffB);
            PG8_WAIT_V(6); PG8_BAR; PG8_MMA(1, 1, At, B1); PG8_BAR;
            }
        }
        if constexpr (ALIGN_EPI) { if (wr == 0) PG8_BAR; }
        if constexpr (!Epi::AFTER_DRAIN) { E(acc, cur, wr, wc, fr, fq); S.done(cur); }
        if (!has_next) break;
#pragma unroll
        for (int a = 0; a < 2; ++a)
#pragma unroll
            for (int b = 0; b < 2; ++b)
#pragma unroll
                for (int m = 0; m < 4; ++m)
#pragma unroll
                    for (int n = 0; n < 2; ++n) acc[a][b][m][n] = (f32x4){0.f, 0.f, 0.f, 0.f};
        cur = nxt; cA = nA; cB = nB; ++ui;
        if constexpr (ALIGN_EPI) { if (wr == 1) PG8_BAR; }
    }
    PG8_WAIT_V(0);
    if constexpr (!ALIGN_EPI) { if (wr == 0) PG8_BAR; }
    PG8_BAR;
    if constexpr (Epi::AFTER_DRAIN) { E.fused(acc, cur, wr, wc, fr, fq, lds, wid, lane); S.done(cur); }
#undef PG8_SA
#undef PG8_SB
#undef PG8_STAGE
#undef PG8_STAGE_AUX
#undef PG8_LDA
#undef PG8_LDB
#undef PG8_MMA
#undef PG8_WAIT_V
#undef PG8_WAIT_L
#undef PG8_BAR
#undef PG8_SCHED
}
}
#ifndef PG8_SP2
#define PG8_SP2 true
#endif
#ifndef PG8_ALIGN
#define PG8_ALIGN true
#endif
#ifndef MK_N_LAUNCHES
#define MK_N_LAUNCHES 1
#endif
constexpr int NB = 16, SEQ = 2048, D = 1024, M = NB * SEQ;
constexpr int NMEM = 256, MM = NB * NMEM;
constexpr int NPROJ = 1792, DFF = 2816, NGU = 2 * DFF, NMKV = 512;
constexpr int C_Q = 0, C_K = 512, C_V = 640, C_CH = 768, C_CB = 1024, C_CC = 1280, C_QM = 1536;
constexpr float EPS = 1e-6f;
constexpr int NWAVES = 8, NPHASE = 6;
constexpr size_t MiB = 1u << 20;
constexpr size_t WS_SLOTS = 0;
constexpr size_t WS_WIN = 2 * MiB, WS_WMKV = 6 * MiB, WS_WOUT = 7 * MiB, WS_WGU = 9 * MiB, WS_WDN = 20 * MiB;
constexpr size_t WS_MEMN = 32 * MiB, WS_MEMKV = 40 * MiB, WS_X1B = 48 * MiB, WS_PROJ = 112 * MiB, WS_XN = 224 * MiB, WS_MERGED = WS_XN, WS_H = 112 * MiB, WS_END = 288 * MiB;
static_assert(WS_WIN + (size_t)NPROJ * D * 2 <= WS_WMKV && WS_WMKV + (size_t)NMKV * D * 2 <= WS_WOUT && WS_WOUT + (size_t)D * D * 2 <= WS_WGU && WS_WGU + (size_t)NGU * D * 2 <= WS_WDN && WS_WDN + (size_t)D * DFF * 2 <= WS_MEMN, "ws weights");
static_assert(WS_MEMN + (size_t)MM * D * 2 <= WS_MEMKV && WS_MEMKV + (size_t)MM * NMKV * 2 <= WS_X1B && WS_X1B + (size_t)M * D * 2 <= WS_PROJ && WS_PROJ + (size_t)M * NPROJ * 2 <= WS_XN && WS_XN + (size_t)M * D * 2 <= WS_END && WS_H + (size_t)M * DFF * 2 <= WS_END, "ws acts");
constexpr size_t WS_CTL = 26 * MiB, CTL_BYTES = 16384;
constexpr int LDS_BYTES = 147456;

#define LAS __attribute__((address_space(3)))
typedef unsigned short bf16;
typedef unsigned v4u __attribute__((ext_vector_type(4)));
typedef unsigned v2u __attribute__((ext_vector_type(2)));
typedef float f32x4 __attribute__((ext_vector_type(4)));
__device__ __forceinline__ unsigned f2bf(float f) { unsigned u = __builtin_bit_cast(unsigned, f); return (u + 0x7fffu + ((u >> 16) & 1u)) >> 16; }
__device__ __forceinline__ unsigned pk2(float lo, float hi) { return f2bf(lo) | (f2bf(hi) << 16); }
__device__ __forceinline__ float bf2f(bf16 v) { return __builtin_bit_cast(float, (unsigned)v << 16); }
__device__ __forceinline__ float bflo(unsigned w) { return __builtin_bit_cast(float, w << 16); }
__device__ __forceinline__ float bfhi(unsigned w) { return __builtin_bit_cast(float, w & 0xffff0000u); }
__device__ __forceinline__ float wave_sum(float v) {
#pragma unroll
    for (int o = 1; o < 64; o <<= 1) v += __shfl_xor(v, o);
    return v;
}
__device__ __forceinline__ float wave_max(float v) {
#pragma unroll
    for (int o = 1; o < 64; o <<= 1) v = fmaxf(v, __shfl_xor(v, o));
    return v;
}

#define XB_TMO      128
#define XB_XCNT(j)  (256  + 64 * (j))
#define XB_XSUB(j)  (1280 + 64 * (j))
#define XB_XGEN(j)  (2304 + 64 * (j))
#define XB_TOP      3328
#define XB_TOPGEN   3392
#define XCD_BAR_WORDS 3456
#define XB_SPIN_CAP (1u << 18)

__device__ __forceinline__ unsigned xb_ld(unsigned* p)              { return __hip_atomic_load(p, __ATOMIC_RELAXED, __HIP_MEMORY_SCOPE_AGENT); }
__device__ __forceinline__ unsigned xb_add(unsigned* p, unsigned v) { return __hip_atomic_fetch_add(p, v, __ATOMIC_RELAXED, __HIP_MEMORY_SCOPE_AGENT); }
__device__ __forceinline__ unsigned xb_xcc_id() { return (unsigned)__builtin_amdgcn_s_getreg((3 << 11) | 20) & 0xFu; }
#define XB_SPIN(cond, bar) do { unsigned _sp = 0; while (cond) { __builtin_amdgcn_s_sleep(1); \
    if ((++_sp & 255u) == 0u) { if (xb_ld(&(bar)[XB_TMO])) break; if (_sp > XB_SPIN_CAP) { atomicAdd(&(bar)[XB_TMO], 1u); break; } } } } while (0)

struct XcdBarrier {
    unsigned* bar; unsigned x;
    volatile LAS unsigned* st;
};

__device__ __forceinline__ XcdBarrier xcd_barrier_post(unsigned* bar, volatile LAS unsigned* st) {
    XcdBarrier b; b.bar = bar; b.x = xb_xcc_id(); b.st = st;
    if (threadIdx.x == 0) (void)xb_add(&bar[XB_XCNT(b.x)], 1u);
    return b;
}
__device__ __forceinline__ void xcd_barrier_complete(unsigned* bar, unsigned x, unsigned& nloc, unsigned& nx) {
    const unsigned G = gridDim.x * gridDim.y * gridDim.z;
    unsigned sum, cnt, mine, sp = 0u;
    for (;;) {
        sum = 0u; cnt = 0u; mine = 0u;
#pragma unroll
        for (unsigned j = 0; j < 16; ++j) { const unsigned c = xb_ld(&bar[XB_XCNT(j)]); sum += c; cnt += (c > 0u) ? 1u : 0u; mine = (j == x) ? c : mine; }
        if (sum == G) break;
        __builtin_amdgcn_s_sleep(1);
        if ((++sp & 255u) == 0u) { if (xb_ld(&bar[XB_TMO])) break; if (sp > XB_SPIN_CAP) { atomicAdd(&bar[XB_TMO], 1u); break; } }
    }
    nloc = mine > 0u ? mine : 1u; nx = cnt > 0u ? cnt : 1u;
}

__device__ __forceinline__ void xcd_barrier(const XcdBarrier& b) {
    asm volatile("s_waitcnt vmcnt(0)" ::: "memory");
    __syncthreads();
    if (threadIdx.x == 0) {
        unsigned* bar = b.bar;
        __builtin_amdgcn_s_waitcnt(0);
        unsigned nloc = b.st[0], nx = b.st[1];
        if (nloc == 0u) { xcd_barrier_complete(bar, b.x, nloc, nx); b.st[0] = nloc; b.st[1] = nx; }
        const unsigned old = xb_add(&bar[XB_XSUB(b.x)], 1u);
        const unsigned gen = old / nloc;
        if (old + 1u == (gen + 1u) * nloc) {
            __builtin_amdgcn_fence(__ATOMIC_RELEASE, "agent");
            asm volatile("s_waitcnt vmcnt(0)" ::: "memory");
            const unsigned og = xb_add(&bar[XB_TOP], 1u);
            const unsigned tg = og / nx;
            if (og + 1u == (tg + 1u) * nx) xb_add(&bar[XB_TOPGEN], 1u);
            else XB_SPIN(xb_ld(&bar[XB_TOPGEN]) == tg, bar);
            __builtin_amdgcn_fence(__ATOMIC_ACQUIRE, "agent");
            xb_add(&bar[XB_XGEN(b.x)], 1u);
            asm volatile("s_waitcnt vmcnt(0)" ::: "memory");
        } else {
            XB_SPIN(xb_ld(&bar[XB_XGEN(b.x)]) == gen, bar);
            __builtin_amdgcn_fence(__ATOMIC_ACQUIRE, "agent");
            asm volatile("s_waitcnt vmcnt(0)" ::: "memory");
        }
    }
    __syncthreads();
}

struct Args { const float* in[21]; float* out; unsigned char* ws; int ph_lo, ph_hi; };
enum { I_X = 0, I_MEM, I_NORM_MIX, I_W_IN, I_Q_NORM, I_K_NORM, I_SINKS, I_CONV_W, I_CONV_B, I_NORM_MEM, I_W_MEM_KV, I_MEM_Q_NORM, I_MEM_K_NORM,
       I_ON_ATTN, I_ON_CONV, I_ON_MEM, I_W_OUT, I_NORM_FFN, I_W_GATE, I_W_UP, I_W_DOWN };

__device__ __forceinline__ void p0_transpose_item(const float* W, int K, int N, bf16* WT, int dst_row0, const float* kscale, LAS float* scr, int k0, int n0, int lane) {
    float v[32];
#pragma unroll
    for (int i = 0; i < 32; ++i) { const int kk = 2 * i + (lane >> 5); v[i] = __builtin_nontemporal_load(W + (size_t)(k0 + kk) * N + n0 + (lane & 31)); }
    if (kscale) {
#pragma unroll
        for (int i = 0; i < 32; ++i) v[i] *= kscale[k0 + 2 * i + (lane >> 5)]; }
#pragma unroll
    for (int i = 0; i < 32; ++i) { const int kk = 2 * i + (lane >> 5); scr[kk * 33 + (lane & 31)] = v[i]; }
    asm volatile("s_waitcnt lgkmcnt(0)" ::: "memory");
    const int c = lane & 7;
#pragma unroll
    for (int j = 0; j < 4; ++j) { const int n = (lane >> 3) + 8 * j; const LAS float* s = scr + (8 * c) * 33 + n;
        v4u o; o.x = pk2(s[0 * 33], s[1 * 33]); o.y = pk2(s[2 * 33], s[3 * 33]); o.z = pk2(s[4 * 33], s[5 * 33]); o.w = pk2(s[6 * 33], s[7 * 33]);
        *(v4u*)(WT + (size_t)(dst_row0 + n) * K + k0 + 8 * c) = o; }
    asm volatile("s_waitcnt lgkmcnt(0)" ::: "memory");
}
constexpr int I_IN = (D / 64) * (NPROJ / 32), I_MK = (D / 64) * (NMKV / 32), I_O = (D / 64) * (D / 32), I_G = (D / 64) * (DFF / 32), I_DN = (DFF / 64) * (D / 32);
constexpr int NITEMS_EARLY = I_IN + I_MK + I_O, NITEMS_LATE = 2 * I_G + I_DN;
__device__ __forceinline__ void p0_weight_item(const Args& a, int it, LAS float* scr, int lane) {
    unsigned char* ws = a.ws; int r = it;
    if (r < I_IN) { const int nb = NPROJ / 32; p0_transpose_item(a.in[I_W_IN], D, NPROJ, (bf16*)(ws + WS_WIN), 32 * (r % nb), nullptr, scr, 64 * (r / nb), 32 * (r % nb), lane); return; } r -= I_IN;
    if (r < I_MK) { const int nb = NMKV / 32; p0_transpose_item(a.in[I_W_MEM_KV], D, NMKV, (bf16*)(ws + WS_WMKV), 32 * (r % nb), nullptr, scr, 64 * (r / nb), 32 * (r % nb), lane); return; } r -= I_MK;
    if (r < I_O) { const int nb = D / 32; const int k0 = 64 * (r / nb);
        const float* ks = k0 < 512 ? a.in[I_ON_ATTN] : (k0 < 768 ? a.in[I_ON_CONV] - 512 : a.in[I_ON_MEM] - 768);
        p0_transpose_item(a.in[I_W_OUT], D, D, (bf16*)(ws + WS_WOUT), 32 * (r % nb), ks, scr, k0, 32 * (r % nb), lane); return; } r -= I_O;
    if (r < 2 * I_G) { const int up = r >= I_G; if (up) r -= I_G; const int nb = DFF / 32, n0 = 32 * (r % nb);
        p0_transpose_item(a.in[up ? I_W_UP : I_W_GATE], D, DFF, (bf16*)(ws + WS_WGU), (n0 / 128) * 256 + up * 128 + (n0 % 128), a.in[I_NORM_FFN], scr, 64 * (r / nb), n0, lane); return; } r -= 2 * I_G;
    { const int nb = D / 32; p0_transpose_item(a.in[I_W_DOWN], DFF, D, (bf16*)(ws + WS_WDN), 32 * (r % nb), nullptr, scr, 64 * (r / nb), 32 * (r % nb), lane); }
}
__device__ __forceinline__ void p0_rows3(const Args& a, int m0, int lane) {
    f32x4 v[3][4]; const float* gp[3]; bf16* op[3];
#pragma unroll
    for (int r = 0; r < 3; ++r) { const int m = m0 + r; const bool isx = m < M;
        const float* src = isx ? a.in[I_X] + (size_t)m * D : a.in[I_MEM] + (size_t)(m - M) * D;
        gp[r] = isx ? a.in[I_NORM_MIX] : a.in[I_NORM_MEM];
        op[r] = isx ? (bf16*)(a.ws + WS_XN) + (size_t)m * D : (bf16*)(a.ws + WS_MEMN) + (size_t)(m - M) * D;
#pragma unroll
        for (int j = 0; j < 4; ++j) v[r][j] = __builtin_nontemporal_load((const f32x4*)src + lane + 64 * j); }
#pragma unroll
    for (int r = 0; r < 3; ++r) { float s = 0.f;
#pragma unroll
        for (int j = 0; j < 4; ++j) s += (v[r][j].x * v[r][j].x + v[r][j].y * v[r][j].y) + (v[r][j].z * v[r][j].z + v[r][j].w * v[r][j].w);
        const float rstd = __builtin_amdgcn_rsqf(wave_sum(s) * (1.f / D) + EPS);
        unsigned long long* o8 = (unsigned long long*)op[r] + lane;
#pragma unroll
        for (int j = 0; j < 4; ++j) { const f32x4 g = ((const f32x4*)gp[r])[lane + 64 * j];
            o8[64 * j] = (unsigned long long)pk2(v[r][j].x * rstd * g.x, v[r][j].y * rstd * g.y) | ((unsigned long long)pk2(v[r][j].z * rstd * g.z, v[r][j].w * rstd * g.w) << 32); } }
}
__device__ __forceinline__ void p0_prologue(const Args& a, LAS unsigned char* lds, int wave, int lane, bool defer_late) {
    LAS float* scr = (LAS float*)(lds + wave * 16384);
    const int gw = blockIdx.x * NWAVES + wave, NGW = gridDim.x * NWAVES;
    const int nitems = defer_late ? NITEMS_EARLY : NITEMS_EARLY + NITEMS_LATE;
    for (int it = gw; it < nitems; it += NGW) p0_weight_item(a, it, scr, lane);
    static_assert((M + MM) % 3 == 0, "rows in threes");
    for (int m0 = 3 * gw; m0 < M + MM; m0 += 3 * NGW) p0_rows3(a, m0, lane);
}
__device__ __forceinline__ void p1_late_weights(const Args& a, LAS unsigned char* lds, int wave, int lane, int wi, int nw) {
    LAS float* scr = (LAS float*)(lds + wave * 16384);
    for (int it = wi * NWAVES + wave; it < NITEMS_LATE; it += nw * NWAVES) p0_weight_item(a, NITEMS_EARLY + it, scr, lane);
}
namespace mx {
typedef short bf16x8 __attribute__((ext_vector_type(8)));
typedef short s16x4 __attribute__((ext_vector_type(4)));
typedef float f32x16 __attribute__((ext_vector_type(16)));
constexpr int KIMG = 0, VIMG = 65536, SSQA = 131072, SSQM = SSQA + 8192;
constexpr float LOG2E = 1.4426950408889634f, NEG = -1e30f;
__device__ __forceinline__ unsigned off_b(unsigned row, unsigned ch) { return 256u * row + 16u * (ch ^ (((row & 3) << 2) | ((row >> 2) & 3))); }
__device__ __forceinline__ void lds_barrier() { asm volatile("s_waitcnt lgkmcnt(0)\n\ts_barrier" ::: "memory"); }
__device__ __forceinline__ int crow(int r, int hi) { return (r & 3) + 8 * (r >> 2) + 4 * hi; }
__device__ __forceinline__ unsigned cvtpk(float lo, float hi) { typedef float f32x2_t __attribute__((ext_vector_type(2))); typedef __bf16 bf16x2_t __attribute__((ext_vector_type(2)));
    const f32x2_t v = {lo, hi}; const bf16x2_t b = __builtin_convertvector(v, bf16x2_t); return __builtin_bit_cast(unsigned, b); }
__device__ __forceinline__ s16x4 vtr(unsigned addr, LAS unsigned char* lds) { typedef short v4i16_t __attribute__((ext_vector_type(4)));
    return __builtin_bit_cast(s16x4, __builtin_amdgcn_ds_read_tr16_b64_v4i16((LAS v4i16_t*)(lds + addr))); }

struct KVRegs { v4u k[8], v[8]; };
__device__ __forceinline__ void issue_kv(KVRegs& R, const bf16* base, long krow0_off, long vrow0_off, int stride, int first_valid, int tid) {
    const bf16* kp = base + krow0_off + (long)(tid >> 4) * stride + (tid & 15) * 8; const bf16* vp = base + vrow0_off + (long)(tid >> 4) * stride + (tid & 15) * 8;
#pragma unroll
    for (int i = 0; i < 8; ++i) { const int row = (tid >> 4) + 32 * i;
        if (row >= first_valid) { R.k[i] = *(const v4u*)(kp + (long)(32 * i) * stride); R.v[i] = *(const v4u*)(vp + (long)(32 * i) * stride); }
        else { R.k[i] = (v4u){0u, 0u, 0u, 0u}; R.v[i] = (v4u){0u, 0u, 0u, 0u}; } }
}
__device__ __forceinline__ void commit_kv(const KVRegs& R, const LAS float* gain  , LAS unsigned char* lds, int tid) {
    const int c7 = (tid & 7) * 8;
    const f32x4 g0 = *(const LAS f32x4*)(gain + c7), g1 = *(const LAS f32x4*)(gain + c7 + 4);
    LAS unsigned char* kdst = lds + KIMG + off_b(tid >> 4, tid & 15);
#pragma unroll
    for (int i = 0; i < 8; ++i) {
        const v4u k = R.k[i];
        float x[8] = {bflo(k.x), bfhi(k.x), bflo(k.y), bfhi(k.y), bflo(k.z), bfhi(k.z), bflo(k.w), bfhi(k.w)};
        float ss = 0.f;
#pragma unroll
        for (int e = 0; e < 8; ++e) ss += x[e] * x[e];
        ss += __shfl_xor(ss, 1); ss += __shfl_xor(ss, 2); ss += __shfl_xor(ss, 4);
        const float rstd = __builtin_amdgcn_rsqf(ss * (1.f / 64) + EPS);
        v4u o; o.x = cvtpk(x[0] * rstd * g0[0], x[1] * rstd * g0[1]); o.y = cvtpk(x[2] * rstd * g0[2], x[3] * rstd * g0[3]);
        o.z = cvtpk(x[4] * rstd * g1[0], x[5] * rstd * g1[1]); o.w = cvtpk(x[6] * rstd * g1[2], x[7] * rstd * g1[3]);
        *(LAS v4u*)(kdst + 8192 * i) = o;
        *(LAS v4u*)(kdst + (VIMG - KIMG) + 8192 * i) = R.v[i]; }
}
struct QRaw { v4u r[4]; };
__device__ __forceinline__ void load_q_raw(QRaw& Q, const bf16* qrow  , int hi) {
#pragma unroll
    for (int d0 = 0; d0 < 4; ++d0) Q.r[d0] = __builtin_nontemporal_load((const v4u*)(qrow + 16 * d0 + 8 * hi));
}
__device__ __forceinline__ void norm_q(bf16x8 (&qf)[4], const QRaw& Q, const LAS float* gain  , float qscale, int hi) {
    float x[4][8]; float ss = 0.f;
#pragma unroll
    for (int d0 = 0; d0 < 4; ++d0) { const v4u k = Q.r[d0];
        x[d0][0] = bflo(k.x); x[d0][1] = bfhi(k.x); x[d0][2] = bflo(k.y); x[d0][3] = bfhi(k.y); x[d0][4] = bflo(k.z); x[d0][5] = bfhi(k.z); x[d0][6] = bflo(k.w); x[d0][7] = bfhi(k.w);
#pragma unroll
        for (int e = 0; e < 8; ++e) ss += x[d0][e] * x[d0][e]; }
    ss += __shfl_xor(ss, 32);
    const float rs = __builtin_amdgcn_rsqf(ss * (1.f / 64) + EPS) * qscale;
#pragma unroll
    for (int d0 = 0; d0 < 4; ++d0) { const f32x4 g0 = *(const LAS f32x4*)(gain + 16 * d0 + 8 * hi), g1 = *(const LAS f32x4*)(gain + 16 * d0 + 8 * hi + 4);
        v4u o; o.x = cvtpk(x[d0][0] * rs * g0[0], x[d0][1] * rs * g0[1]); o.y = cvtpk(x[d0][2] * rs * g0[2], x[d0][3] * rs * g0[3]);
        o.z = cvtpk(x[d0][4] * rs * g1[0], x[d0][5] * rs * g1[1]); o.w = cvtpk(x[d0][6] * rs * g1[2], x[d0][7] * rs * g1[3]);
        qf[d0] = __builtin_bit_cast(bf16x8, o); }
}
struct TileAddr { unsigned kb[4], vb[2][2]; };
__device__ __forceinline__ TileAddr tile_addr(int kvsel, int lane) {
    TileAddr A; const unsigned r32 = lane & 31, hi = lane >> 5, blk = (lane >> 4) & 1, qq = (lane & 15) >> 2, p = lane & 3;
#pragma unroll
    for (int d0 = 0; d0 < 4; ++d0) A.kb[d0] = KIMG + off_b(r32, 8 * kvsel + 2 * d0 + hi);
#pragma unroll
    for (int db = 0; db < 2; ++db)
#pragma unroll
        for (int t8 = 0; t8 < 2; ++t8) A.vb[db][t8] = VIMG + off_b(4 * hi + qq + 8 * t8, 4 * (2 * kvsel + db) + 2 * blk + (p >> 1)) + 8 * (p & 1);
    return A;
}
template <int EDGE, int TOFF>
__device__ __forceinline__ void attn_tile(LAS unsigned char* lds, const TileAddr& A, const bf16x8 (&qf)[4], const f32x16& cinit, float ck, f32x16 (&o)[2], f32x16& lacc, int lane) {
    const int r32 = lane & 31, hi = lane >> 5;
    bf16x8 kf[4]; s16x4 vlo[2][2], vhh[2][2];
#pragma unroll
    for (int d0 = 0; d0 < 4; ++d0) kf[d0] = *(const LAS bf16x8*)(lds + A.kb[d0] + TOFF);
#pragma unroll
    for (int db = 0; db < 2; ++db)
#pragma unroll
        for (int ks = 0; ks < 2; ++ks) { vlo[db][ks] = vtr(A.vb[db][0] + (TOFF + 4096 * ks), lds); vhh[db][ks] = vtr(A.vb[db][1] + (TOFF + 4096 * ks), lds); }
    __builtin_amdgcn_sched_barrier(0);
    f32x16 s;
#pragma unroll
    for (int d0 = 0; d0 < 4; ++d0) { if (d0 == 0) s = __builtin_amdgcn_mfma_f32_32x32x16_bf16(kf[d0], qf[d0], cinit, 0, 0, 0); else s = __builtin_amdgcn_mfma_f32_32x32x16_bf16(kf[d0], qf[d0], s, 0, 0, 0); }
#pragma unroll
    for (int r = 0; r < 16; ++r) { float p = __builtin_amdgcn_exp2f(s[r] + ck);
        if (EDGE == 1) p = (crow(r, hi) > r32) ? p : 0.f;
        if (EDGE == 2) p = (crow(r, hi) <= r32) ? p : 0.f;
        s[r] = p; }
    bf16x8 pa[2];
#pragma unroll
    for (int ks = 0; ks < 2; ++ks) { v4u w; w.x = cvtpk(s[8 * ks], s[8 * ks + 1]); w.y = cvtpk(s[8 * ks + 2], s[8 * ks + 3]); w.z = cvtpk(s[8 * ks + 4], s[8 * ks + 5]); w.w = cvtpk(s[8 * ks + 6], s[8 * ks + 7]);
        pa[ks] = __builtin_bit_cast(bf16x8, w); }
    const bf16x8 ones = {(short)0x3F80, (short)0x3F80, (short)0x3F80, (short)0x3F80, (short)0x3F80, (short)0x3F80, (short)0x3F80, (short)0x3F80};
#pragma unroll
    for (int ks = 0; ks < 2; ++ks) lacc = __builtin_amdgcn_mfma_f32_32x32x16_bf16(ones, pa[ks], lacc, 0, 0, 0);
#pragma unroll
    for (int db = 0; db < 2; ++db)
#pragma unroll
        for (int ks = 0; ks < 2; ++ks) {
            const bf16x8 vf = __builtin_shufflevector(vlo[db][ks], vhh[db][ks], 0, 1, 2, 3, 4, 5, 6, 7);
            o[db] = __builtin_amdgcn_mfma_f32_32x32x16_bf16(vf, pa[ks], o[db], 0, 0, 0); }
}
__device__ __forceinline__ TileAddr tile_addr_add(const TileAddr& A, unsigned off) { TileAddr B;
#pragma unroll
    for (int d0 = 0; d0 < 4; ++d0) B.kb[d0] = A.kb[d0] + off;
#pragma unroll
    for (int db = 0; db < 2; ++db)
#pragma unroll
        for (int t8 = 0; t8 < 2; ++t8) B.vb[db][t8] = A.vb[db][t8] + off;
    return B; }
__device__ __forceinline__ void zero_o(f32x16 (&o)[2]) {
#pragma unroll
    for (int db = 0; db < 2; ++db)
#pragma unroll
        for (int r = 0; r < 16; ++r) o[db][r] = 0.f;
}
__device__ __forceinline__ void store_o(const f32x16 (&o)[2], float scale, bf16* orow  , int hi) {
    bf16* dst = orow + (hi ? 8 : 0);
#pragma unroll
    for (int db = 0; db < 2; ++db)
#pragma unroll
        for (int g = 0; g < 4; g += 2) {
            unsigned ax = cvtpk(o[db][4 * g] * scale, o[db][4 * g + 1] * scale), ay = cvtpk(o[db][4 * g + 2] * scale, o[db][4 * g + 3] * scale);
            unsigned bx = cvtpk(o[db][4 * g + 4] * scale, o[db][4 * g + 5] * scale), by = cvtpk(o[db][4 * g + 6] * scale, o[db][4 * g + 7] * scale);
            { auto r = __builtin_amdgcn_permlane32_swap(ax, bx, false, false); ax = r[0]; bx = r[1]; }
            { auto r = __builtin_amdgcn_permlane32_swap(ay, by, false, false); ay = r[0]; by = r[1]; }
            *(v4u*)(dst + 32 * db + 8 * g) = (v4u){ax, ay, bx, by}; }
}
__device__ __forceinline__ float sumsq_o(const f32x16 (&o)[2]) { float s = 0.f;
#pragma unroll
    for (int db = 0; db < 2; ++db)
#pragma unroll
        for (int r = 0; r < 16; ++r) s += o[db][r] * o[db][r];
    return s; }
}

__device__ __forceinline__ void mixer_fast(const Args& a, LAS unsigned char* lds, int wave, int lane) {
    using namespace mx;
    const int tid = threadIdx.x, r32 = lane & 31, hi = lane >> 5;
    const bf16* PROJ = (const bf16*)(a.ws + WS_PROJ); const bf16* MEMKV = (const bf16*)(a.ws + WS_MEMKV); bf16* MERGED = (bf16*)(a.ws + WS_MERGED);
    LAS float* ssqa = (LAS float*)(lds + SSQA);
    LAS float* ssqm = (LAS float*)(lds + SSQM);
    LAS float* gtab = (LAS float*)(lds + 143360);
    if (wave == 0) gtab[lane] = a.in[I_Q_NORM][lane];
    if (wave == 1) gtab[64 + lane] = a.in[I_K_NORM][lane];
    if (wave == 2) gtab[128 + lane] = a.in[I_MEM_Q_NORM][lane];
    if (wave == 3) gtab[192 + lane] = a.in[I_MEM_K_NORM][lane];
    __syncthreads();
    const float refa = 8.16f * LOG2E * wave_max(fabsf(gtab[lane])) * wave_max(fabsf(gtab[64 + lane]));
    const float refm = 8.16f * LOG2E * wave_max(fabsf(gtab[128 + lane])) * wave_max(fabsf(gtab[192 + lane]));
    const int h = wave, kvsel_a = h >> 2; const float slope2 = exp2f(-(float)(h + 1)) * LOG2E, sink2 = a.in[I_SINKS][h] * LOG2E;
    const float mfix = fmaxf(refa, sink2);
    f32x16 cbias;
#pragma unroll
    for (int r = 0; r < 16; ++r) { cbias[r] = -slope2 * (float)(128 + r32 - crow(r, hi)) - mfix; }
    for (int u0 = blockIdx.x; u0 < NB * (SEQ / 128); u0 += gridDim.x) {
        const int u = (gridDim.x == 256) ? (u0 & 7) * 32 + (u0 >> 3) : u0;
        const int b = u / (SEQ / 128), n = u % (SEQ / 128); const long tok0 = (long)b * SEQ + n * 128;
        KVRegs R;
        lds_barrier();
        issue_kv(R, PROJ, (tok0 - 128) * NPROJ + C_K, (tok0 - 128) * NPROJ + C_V, NPROJ, n > 0 ? 0 : 128, tid);
        commit_kv(R, gtab + 64, lds, tid);
        int r32a = r32; asm volatile("" : "+v"(r32a));
        QRaw QR; load_q_raw(QR, PROJ + (tok0 + r32a) * NPROJ + C_Q + h * 64, hi);
        lds_barrier();
        {
            const bool has_prev = n > 0; int lane_a = lane; asm volatile("" : "+v"(lane_a)); const TileAddr TA = tile_addr(kvsel_a, lane_a);
#pragma unroll 1
            for (int j = 0; j < 4; ++j) {
                bf16x8 qf[4]; norm_q(qf, QR, gtab, 0.125f * LOG2E, hi);
                if (j < 3) load_q_raw(QR, PROJ + (tok0 + 32 * (j + 1) + r32a) * NPROJ + C_Q + h * 64, hi);
                else load_q_raw(QR, PROJ + (tok0 + 32 * (wave >> 1) + r32a) * NPROJ + C_QM + (wave & 1) * 64, hi);
                f32x16 o[2]; zero_o(o); f32x16 lacc;
#pragma unroll
                for (int r = 0; r < 16; ++r) lacc[r] = 0.f;
                const TileAddr TJ = tile_addr_add(TA, 8192u * j);
                if (has_prev || j >= 4) attn_tile<1, 0>(lds, TJ, qf, cbias, 0.f, o, lacc, lane);
                if (has_prev || j >= 3) attn_tile<0, 8192>(lds, TJ, qf, cbias, 32.f * slope2, o, lacc, lane);
                if (has_prev || j >= 2) attn_tile<0, 16384>(lds, TJ, qf, cbias, 64.f * slope2, o, lacc, lane);
                if (has_prev || j >= 1) attn_tile<0, 24576>(lds, TJ, qf, cbias, 96.f * slope2, o, lacc, lane);
                attn_tile<2, 32768>(lds, TJ, qf, cbias, 128.f * slope2, o, lacc, lane);
                const float inv = __builtin_amdgcn_rcpf(lacc[0] + __builtin_amdgcn_exp2f(sink2 - mfix));
#pragma unroll
                for (int db = 0; db < 2; ++db)
#pragma unroll
                    for (int r = 0; r < 16; ++r) o[db][r] *= inv;
                float ss = sumsq_o(o); ss += __shfl_xor(ss, 32);
                if (hi == 0) ssqa[((j & 1) * 128 + 32 * j + r32) * 8 + h] = ss;
                lds_barrier();
                const LAS f32x4* sp = (const LAS f32x4*)(ssqa + ((j & 1) * 128 + 32 * j + r32) * 8); const f32x4 s0 = sp[0], s1 = sp[1];
                const float tot = ((s0[0] + s0[1]) + (s0[2] + s0[3])) + ((s1[0] + s1[1]) + (s1[2] + s1[3]));
                store_o(o, __builtin_amdgcn_rsqf(tot * (1.f / 512) + EPS), MERGED + (tok0 + 32 * j + r32a) * D + h * 64, hi);
            }
        }
        {
            int lane_m = lane; asm volatile("" : "+v"(lane_m));
            const int hs = wave & 1, jq = wave >> 1; const TileAddr TA = tile_addr(hs, lane_m);
            f32x16 om[2][2]; f32x16 cneg;
#pragma unroll
            for (int r = 0; r < 16; ++r) cneg[r] = -refm;
#pragma unroll
            for (int pass = 0; pass < 2; ++pass) {
                lds_barrier();
                issue_kv(R, MEMKV, (long)b * NMEM * NMKV + 128 * pass, (long)b * NMEM * NMKV + 256 + 128 * pass, NMKV, 0, tid);
                commit_kv(R, gtab + 192, lds, tid);
                lds_barrier();
                const int hm = 2 * pass + hs;
                bf16x8 qf[4]; norm_q(qf, QR, gtab + 128, 0.125f * LOG2E, hi);
                if (pass == 0) load_q_raw(QR, PROJ + (tok0 + 32 * jq + r32) * NPROJ + C_QM + (2 + hs) * 64, hi);
                zero_o(om[pass]); f32x16 lacc;
#pragma unroll
                for (int r = 0; r < 16; ++r) lacc[r] = 0.f;
                attn_tile<0, 0>(lds, TA, qf, cneg, 0.f, om[pass], lacc, lane);     attn_tile<0, 8192>(lds, TA, qf, cneg, 0.f, om[pass], lacc, lane);
                attn_tile<0, 16384>(lds, TA, qf, cneg, 0.f, om[pass], lacc, lane); attn_tile<0, 24576>(lds, TA, qf, cneg, 0.f, om[pass], lacc, lane);
                attn_tile<0, 32768>(lds, TA, qf, cneg, 0.f, om[pass], lacc, lane); attn_tile<0, 40960>(lds, TA, qf, cneg, 0.f, om[pass], lacc, lane);
                attn_tile<0, 49152>(lds, TA, qf, cneg, 0.f, om[pass], lacc, lane); attn_tile<0, 57344>(lds, TA, qf, cneg, 0.f, om[pass], lacc, lane);
                const float inv = __builtin_amdgcn_rcpf(lacc[0]);
#pragma unroll
                for (int db = 0; db < 2; ++db)
#pragma unroll
                    for (int r = 0; r < 16; ++r) om[pass][db][r] *= inv;
            }
            float ss = sumsq_o(om[0]) + sumsq_o(om[1]); ss += __shfl_xor(ss, 32);
            if (hi == 0) ssqm[(32 * jq + r32) * 2 + hs] = ss;
            lds_barrier();
            const float tot = ssqm[(32 * jq + r32) * 2] + ssqm[(32 * jq + r32) * 2 + 1];
            const float rstd = __builtin_amdgcn_rsqf(tot * (1.f / 256) + EPS);
#pragma unroll
            for (int pass = 0; pass < 2; ++pass) { const int hm = 2 * pass + hs;
                store_o(om[pass], rstd, MERGED + (tok0 + 32 * jq + r32) * D + 768 + hm * 64, hi); }
        }
        {
            int tid_c = tid; asm volatile("" : "+v"(tid_c));
            const int c8 = (tid_c & 31) * 8, tg = tid_c >> 5;
            float w0[8], w1[8], w2[8], cb[8];
            const float* cw = a.in[I_CONV_W];
#pragma unroll
            for (int e = 0; e < 8; ++e) { w0[e] = cw[c8 + e]; w1[e] = cw[256 + c8 + e]; w2[e] = cw[512 + c8 + e]; cb[e] = a.in[I_CONV_B][c8 + e]; }
            float um2[8], um1[8];
            const int tseq0 = n * 128 + 8 * tg;
#pragma unroll
            for (int k = 0; k < 2; ++k) { float (&dst)[8] = k == 0 ? um2 : um1;
                if (tseq0 - 2 + k >= 0) { const bf16* r = PROJ + (tok0 + 8 * tg - 2 + k) * NPROJ; const v4u hh = __builtin_nontemporal_load((const v4u*)(r + C_CH + c8)), cc = __builtin_nontemporal_load((const v4u*)(r + C_CC + c8));
                    dst[0] = bflo(hh.x) * bflo(cc.x); dst[1] = bfhi(hh.x) * bfhi(cc.x); dst[2] = bflo(hh.y) * bflo(cc.y); dst[3] = bfhi(hh.y) * bfhi(cc.y);
                    dst[4] = bflo(hh.z) * bflo(cc.z); dst[5] = bfhi(hh.z) * bfhi(cc.z); dst[6] = bflo(hh.w) * bflo(cc.w); dst[7] = bfhi(hh.w) * bfhi(cc.w); }
                else {
#pragma unroll
                    for (int e = 0; e < 8; ++e) dst[e] = 0.f; } }
#pragma unroll
            for (int i0 = 0; i0 < 8; i0 += 4) {
                v4u hh4[4], cc4[4], bb4[4];
#pragma unroll
                for (int i = 0; i < 4; ++i) { const bf16* r = PROJ + (tok0 + 8 * tg + i0 + i) * NPROJ; hh4[i] = __builtin_nontemporal_load((const v4u*)(r + C_CH + c8)); cc4[i] = __builtin_nontemporal_load((const v4u*)(r + C_CC + c8)); bb4[i] = __builtin_nontemporal_load((const v4u*)(r + C_CB + c8)); }
#pragma unroll
                for (int i = 0; i < 4; ++i) { const long tok = tok0 + 8 * tg + i0 + i; const v4u hh = hh4[i], cc = cc4[i], bb = bb4[i];
                    float uc[8] = {bflo(hh.x) * bflo(cc.x), bfhi(hh.x) * bfhi(cc.x), bflo(hh.y) * bflo(cc.y), bfhi(hh.y) * bfhi(cc.y), bflo(hh.z) * bflo(cc.z), bfhi(hh.z) * bfhi(cc.z), bflo(hh.w) * bflo(cc.w), bfhi(hh.w) * bfhi(cc.w)};
                    const float bg[8] = {bflo(bb.x), bfhi(bb.x), bflo(bb.y), bfhi(bb.y), bflo(bb.z), bfhi(bb.z), bflo(bb.w), bfhi(bb.w)};
                    float ov[8], ss = 0.f;
#pragma unroll
                    for (int e = 0; e < 8; ++e) { ov[e] = bg[e] * (w0[e] * um2[e] + w1[e] * um1[e] + w2[e] * uc[e] + cb[e]); ss += ov[e] * ov[e]; um2[e] = um1[e]; um1[e] = uc[e]; }
                    ss += __shfl_xor(ss, 1); ss += __shfl_xor(ss, 2); ss += __shfl_xor(ss, 4); ss += __shfl_xor(ss, 8); ss += __shfl_xor(ss, 16);
                    const float rstd = __builtin_amdgcn_rsqf(ss * (1.f / 256) + EPS);
                    v4u w; w.x = cvtpk(ov[0] * rstd, ov[1] * rstd); w.y = cvtpk(ov[2] * rstd, ov[3] * rstd); w.z = cvtpk(ov[4] * rstd, ov[5] * rstd); w.w = cvtpk(ov[6] * rstd, ov[7] * rstd);
                    *(v4u*)(MERGED + tok * D + 512 + c8) = w; }
            }
        }
    }
}
__global__ void __launch_bounds__(NWAVES * 64, 2) fwd_megakernel(Args args) {
    extern __shared__ __attribute__((aligned(16))) unsigned char lds_raw[];
    LAS unsigned char* lds = (LAS unsigned char*)lds_raw;
    cg::grid_group grid = cg::this_grid();
    const int tid = threadIdx.x, lane = tid & 63, wave = __builtin_amdgcn_readfirstlane(tid >> 6);
    const int lo = args.ph_lo, hi = args.ph_hi, G = gridDim.x;
    unsigned char* ws = args.ws;
    volatile LAS unsigned* MISC = (volatile LAS unsigned*)(lds + LDS_BYTES - 256);
    if (tid < 64) MISC[tid] = 0u;
    __syncthreads();
    XcdBarrier bar; bar.bar = (unsigned*)(ws + WS_CTL); bar.x = 0; bar.st = nullptr;
    if (hi - lo > 1) bar = xcd_barrier_post((unsigned*)(ws + WS_CTL), MISC + 8);
    if (hi < 0) grid.sync();
#define IN(k) (lo <= (k) && (k) < hi)
#define SEAM(k) do { if (IN(k) && IN((k) + 1)) xcd_barrier(bar); } while (0)
    const bool defer_late = (G == 256) && (hi - lo > 1);
    if (IN(0)) { p0_prologue(args, lds, wave, lane, defer_late); }
    SEAM(0);
    if (IN(1)) {
        { pg8::Gemm g{(const bf16*)(ws + WS_XN), (const bf16*)(ws + WS_WIN), M, NPROJ, D, 0}; pg8::StaticOrder S; S.init(M, NPROJ, G, (int)blockIdx.x);
          pg8::EpiStoreBf16 E{(bf16*)(ws + WS_PROJ), NPROJ};
          pg8::gemm_phase<pg8::EpiStoreBf16, pg8::StaticOrder, PG8_ALIGN, PG8_SP2>(lds, g, S, E); }
        { pg8::Gemm g{(const bf16*)(ws + WS_MEMN), (const bf16*)(ws + WS_WMKV), MM, NMKV, D, 0}; pg8::StaticOrder S; S.init(MM, NMKV, G, (int)((blockIdx.x + G / 2) % G));
          pg8::EpiStoreBf16 E{(bf16*)(ws + WS_MEMKV), NMKV};
          pg8::gemm_phase<pg8::EpiStoreBf16, pg8::StaticOrder, PG8_ALIGN, PG8_SP2>(lds, g, S, E); }
        if (defer_late && blockIdx.x >= 160) { __syncthreads(); p1_late_weights(args, lds, wave, lane, (int)blockIdx.x - 160, 96); }
    }
    SEAM(1);
    if (IN(2)) { MIXER(args, lds, wave, lane); }
    SEAM(2);
    if (IN(3)) {
        pg8::Gemm g{(const bf16*)(ws + WS_MERGED), (const bf16*)(ws + WS_WOUT), M, D, D, 0}; pg8::StaticOrder S; S.init(M, D, G, (int)blockIdx.x);
        pg8::EpiOutProj E{args.in[I_X], (bf16*)(ws + WS_X1B), (float*)(ws + WS_SLOTS), D};
        pg8::gemm_phase<pg8::EpiOutProj, pg8::StaticOrder, PG8_ALIGN, PG8_SP2>(lds, g, S, E);
    }
    SEAM(3);
    if (IN(4)) {
        pg8::Gemm g{(const bf16*)(ws + WS_X1B), (const bf16*)(ws + WS_WGU), M, NGU, D, 0}; pg8::StaticOrder S; S.init(M, NGU, G, (int)blockIdx.x);
        LAS float* rtab = (LAS float*)(lds + 131072); int tpm[4] = {-1, -1, -1, -1}; int np = 0; bool tab_ok = true;
        { pg8::Unit uu; for (int i = 0; S.next(i, uu); ++i) { if (uu.pm == tpm[0] || uu.pm == tpm[1] || uu.pm == tpm[2] || uu.pm == tpm[3]) continue;
              if (np == 0) tpm[0] = uu.pm; else if (np == 1) tpm[1] = uu.pm; else if (np == 2) tpm[2] = uu.pm; else if (np == 3) tpm[3] = uu.pm; else tab_ok = false; ++np; } }
        if (tab_ok) {
#pragma unroll
            for (int p = 0; p < 4; ++p) if (p < np) { const int row = tid >> 1, half = tid & 1;
                const f32x4* sp = (const f32x4*)((const float*)(ws + WS_SLOTS) + ((size_t)tpm[p] * 256 + row) * 16 + half * 8); const f32x4 s0 = sp[0], s1 = sp[1];
                float ssum = ((s0[0] + s0[1]) + (s0[2] + s0[3])) + ((s1[0] + s1[1]) + (s1[2] + s1[3])); ssum += __shfl_xor(ssum, 1);
                if (half == 0) rtab[p * 256 + row] = __builtin_amdgcn_rsqf(ssum * (1.f / D) + EPS); }
            __syncthreads();
        }
        pg8::EpiSwiGLU E{(bf16*)(ws + WS_H), DFF, (const float*)(ws + WS_SLOTS), 1.f / D, EPS, rtab, tpm[0], tpm[1], tpm[2], tpm[3], tab_ok};
        pg8::gemm_phase<pg8::EpiSwiGLU, pg8::StaticOrder, PG8_ALIGN, PG8_SP2>(lds, g, S, E);
    }
    SEAM(4);
    if (IN(5)) {
        pg8::Gemm g{(const bf16*)(ws + WS_H), (const bf16*)(ws + WS_WDN), M, D, DFF, 1}; pg8::RevOrder S; S.init(M, D, G, (int)blockIdx.x);
        pg8::EpiDown E{(const bf16*)(ws + WS_X1B), args.out, D};
        pg8::gemm_phase<pg8::EpiDown, pg8::RevOrder, PG8_ALIGN, PG8_SP2>(lds, g, S, E);
    }
#undef IN
#undef SEAM
}

extern "C" void kernel_launch(void* const* d_in, const int* in_sizes, int n_in, void* d_out, int out_size, void* d_ws, size_t ws_size, hipStream_t stream) {
    static int grid = 0;
    if (grid == 0) {
        if (n_in != 21 || in_sizes[0] != M * D || out_size != M * D || ws_size < WS_END) { fprintf(stderr, "kernel_launch: unexpected shapes (n_in %d, in0 %d, out %d, ws %zu); nothing launched\n", n_in, n_in > 0 ? in_sizes[0] : -1, out_size, ws_size); grid = -1; return; }
        int dev = 0, cus = 0, per_cu = 0;
        if (hipGetDevice(&dev) != hipSuccess || hipDeviceGetAttribute(&cus, hipDeviceAttributeMultiprocessorCount, dev) != hipSuccess) { grid = -1; return; }
        if (hipFuncSetAttribute((const void*)fwd_megakernel, hipFuncAttributeMaxDynamicSharedMemorySize, LDS_BYTES) != hipSuccess) { fprintf(stderr, "kernel_launch: hipFuncSetAttribute failed\n"); grid = -1; return; }
        if (hipOccupancyMaxActiveBlocksPerMultiprocessor(&per_cu, (const void*)fwd_megakernel, NWAVES * 64, LDS_BYTES) != hipSuccess || per_cu < 1) { fprintf(stderr, "kernel_launch: occupancy query says %d\n", per_cu); per_cu = 1; }
        (void)hipGetLastError();
        grid = cus * (per_cu > 1 ? 1 : per_cu);
    }
    if (grid < 0) return;
    if (hipMemsetAsync((unsigned char*)d_ws + WS_CTL, 0, CTL_BYTES, stream) != hipSuccess) { fprintf(stderr, "kernel_launch: memset failed\n"); return; }
    Args a{};
    for (int i = 0; i < 21; ++i) a.in[i] = (const float*)d_in[i];
    a.out = (float*)d_out; a.ws = (unsigned char*)d_ws;
#if MK_N_LAUNCHES == 1
    a.ph_lo = 0; a.ph_hi = NPHASE;
    void* kargs[] = {&a};
    hipError_t e = hipLaunchCooperativeKernel((const void*)fwd_megakernel, dim3(grid), dim3(NWAVES * 64), kargs, LDS_BYTES, stream);
    if (e != hipSuccess) fprintf(stderr, "kernel_launch: cooperative launch failed: %s (grid %d)\n", hipGetErrorString(e), grid);
#else
    for (int p = 0; p < NPHASE; ++p) { a.ph_lo = p; a.ph_hi = p + 1;
        hipLaunchKernelGGL(fwd_megakernel, dim3(grid), dim3(NWAVES * 64), LDS_BYTES, stream, a); }
#endif
}
```

```cpp
#include <hip/hip_runtime.h>
#include <hip/hip_cooperative_groups.h>
#include <cstdio>
#include <cstdint>
namespace cg = cooperative_groups;
#define MK_N_LAUNCHES 1
#define MIXER mixer_fast
namespace pg8 {
#define PG8_LAS __attribute__((address_space(3)))
typedef unsigned short bf16_t;
typedef short bf16x8 __attribute__((ext_vector_type(8)));
typedef float f32x4 __attribute__((ext_vector_type(4)));
typedef unsigned u32x4 __attribute__((ext_vector_type(4)));
constexpr int BM = 256, BK = 64, HALF = 128, HTB = HALF * BK * 2  , STAGE_BYTES = 8 * HTB, NXCD = 8, WGM = 8;

__host__ __device__ __forceinline__ int lds_byte(int r, int c) { const int st = (r >> 4) * 2 + (c >> 5), rr = r & 15, cc = c & 31, ob = rr * 64 + cc * 2; return st * 1024 + (ob ^ (((ob >> 9) & 1) << 5)); }
__host__ __device__ __forceinline__ void stage_rc(int b, int& R, int& C) { const int st = b / 1024, sb = b % 1024, swz = sb ^ (((sb >> 9) & 1) << 5); R = (st >> 1) * 16 + swz / 64; C = (st & 1) * 32 + (swz % 64) / 2; }
__host__ __device__ __forceinline__ int perm32(int rho) { const int n = rho >> 4, i = rho & 15; return 8 * (i >> 2) + 4 * n + (i & 3); }

struct Unit { int pm, pn; };
struct Gemm { const bf16_t* A; const bf16_t* Bt; int M, N, K; int a_tiled; };

struct StaticOrder {
    int nM, nN, nwg, G, c;
    __host__ __device__ void init(int M, int N, int G_, int c_) { nM = M / BM; nN = N / BM; nwg = nM * nN; G = G_; c = c_; }
    __host__ __device__ bool next(int i, Unit& u) const {
        const long L = (long)i * G + c; if (L >= nwg) return false;
        int wgid = (int)L; { const int q = nwg / NXCD, r = nwg % NXCD, xcd = wgid % NXCD, off = wgid / NXCD; wgid = (xcd < r ? xcd * (q + 1) : r * (q + 1) + (xcd - r) * q) + off; }
        const int nig = WGM * nN, gid = wgid / nig, fm = gid * WGM, gsz = (nM - fm) < WGM ? (nM - fm) : WGM;
        u.pm = fm + ((wgid % nig) % gsz); u.pn = (wgid % nig) / gsz; return true;
    }
    __device__ __forceinline__ void a_ready(const Unit&) const {}
    __device__ __forceinline__ void done(const Unit&) const {}
};

struct RevOrder : StaticOrder {
    int nr;
    __host__ __device__ void init(int M, int N, int G_, int c_) { StaticOrder::init(M, N, G_, c_); nr = (nwg % G == 0) ? nwg / G : 0; }
    __host__ __device__ bool next(int i, Unit& u) const { if (nr == 0) return StaticOrder::next(i, u); return i < nr ? StaticOrder::next(nr - 1 - i, u) : false; }
};

__device__ __forceinline__ unsigned cvt_pk_bf16(float lo, float hi) { typedef float f32x2_t __attribute__((ext_vector_type(2))); typedef __bf16 bf16x2_t __attribute__((ext_vector_type(2)));
    const f32x2_t v = {lo, hi}; const bf16x2_t b = __builtin_convertvector(v, bf16x2_t); return __builtin_bit_cast(unsigned, b); }
typedef float f32x2 __attribute__((ext_vector_type(2)));
#ifdef NT_STORE
#define EPI_ST(p, v) __builtin_nontemporal_store((v), (p))
#else
#define EPI_ST(p, v) (*(p) = (v))
#endif
struct EpiStoreBf16 {
    static constexpr bool PERM = true, AFTER_DRAIN = false;
    bf16_t* O; int ldc;
    __device__ __forceinline__ void operator()(const f32x4 (&acc)[2][2][4][2], const Unit& u, int wr, int wc, int fr, int fq) const {
        const int row0 = u.pm * BM + wr * 64 + fr, col0 = u.pn * BM + wc * 32 + 8 * fq;
#pragma unroll
        for (int ai = 0; ai < 2; ++ai)
#pragma unroll
            for (int m = 0; m < 4; ++m) { bf16_t* rowp = O + (size_t)(row0 + ai * HALF + m * 16) * ldc + col0;
#pragma unroll
                for (int bj = 0; bj < 2; ++bj) { const f32x4 v0 = acc[ai][bj][m][0], v1 = acc[ai][bj][m][1];
                    u32x4 w; w.x = cvt_pk_bf16(v0[0], v0[1]); w.y = cvt_pk_bf16(v0[2], v0[3]); w.z = cvt_pk_bf16(v1[0], v1[1]); w.w = cvt_pk_bf16(v1[2], v1[3]);
                    EPI_ST((u32x4*)(rowp + bj * HALF), w); } }
    }
};
struct EpiOutProj {
    static constexpr bool PERM = true, AFTER_DRAIN = false;
    const float* X; bf16_t* X1B; float* slots; int ldc;
    __device__ __forceinline__ void operator()(const f32x4 (&acc)[2][2][4][2], const Unit& u, int wr, int wc, int fr, int fq) const {
        const int row0 = u.pm * BM + wr * 64 + fr, col0 = u.pn * BM + wc * 32 + 8 * fq;
#pragma unroll
        for (int ai = 0; ai < 2; ++ai) {
            f32x4 xv[4][2][2];
#pragma unroll
            for (int m = 0; m < 4; ++m)
#pragma unroll
                for (int bj = 0; bj < 2; ++bj) { const float* p = X + (size_t)(row0 + ai * HALF + m * 16) * ldc + col0 + bj * HALF; xv[m][bj][0] = __builtin_nontemporal_load((const f32x4*)p); xv[m][bj][1] = __builtin_nontemporal_load((const f32x4*)(p + 4)); }
            __builtin_amdgcn_sched_barrier(0);
#pragma unroll
            for (int m = 0; m < 4; ++m) { const int row = row0 + ai * HALF + m * 16; const size_t off = (size_t)row * ldc + col0; float ss = 0.f;
#pragma unroll
                for (int bj = 0; bj < 2; ++bj) {
                    const f32x4 v0 = acc[ai][bj][m][0] + xv[m][bj][0], v1 = acc[ai][bj][m][1] + xv[m][bj][1];
                    u32x4 w; w.x = cvt_pk_bf16(v0[0], v0[1]); w.y = cvt_pk_bf16(v0[2], v0[3]); w.z = cvt_pk_bf16(v1[0], v1[1]); w.w = cvt_pk_bf16(v1[2], v1[3]);
                    EPI_ST((u32x4*)(X1B + off + bj * HALF), w);
                    ss += (v0[0] * v0[0] + v0[1] * v0[1]) + (v0[2] * v0[2] + v0[3] * v0[3]) + (v1[0] * v1[0] + v1[1] * v1[1]) + (v1[2] * v1[2] + v1[3] * v1[3]); }
                ss += __shfl_xor(ss, 16); ss += __shfl_xor(ss, 32);
                if (fq == 0) slots[(size_t)row * 16 + u.pn * 4 + wc] = ss; }
            __builtin_amdgcn_sched_barrier(0);
        }
    }
};
struct EpiSwiGLU {
    static constexpr bool PERM = true, AFTER_DRAIN = false;
    bf16_t* H; int ldh; const float* slots; float inv_d, eps; const PG8_LAS float* tab; int tpm0, tpm1, tpm2, tpm3; bool use_tab;
    __device__ __forceinline__ void operator()(const f32x4 (&acc)[2][2][4][2], const Unit& u, int wr, int wc, int fr, int fq) const {
        const int rl0 = wr * 64 + fr, row0 = u.pm * BM + rl0, col0 = u.pn * HALF + wc * 32 + 8 * fq;
        const int tslot = (u.pm == tpm0) ? 0 : (u.pm == tpm1) ? 256 : (u.pm == tpm2) ? 512 : 768;
#pragma unroll
        for (int ai = 0; ai < 2; ++ai)
#pragma unroll
            for (int m = 0; m < 4; ++m) { const int row = row0 + ai * HALF + m * 16;
                float r;
                if (use_tab) r = tab[tslot + rl0 + ai * HALF + m * 16];
                else { const f32x4* sp = (const f32x4*)(slots + (size_t)row * 16); const f32x4 s0 = sp[0], s1 = sp[1], s2 = sp[2], s3 = sp[3];
                    const f32x4 st = (s0 + s1) + (s2 + s3); r = __builtin_amdgcn_rsqf(((st[0] + st[1]) + (st[2] + st[3])) * inv_d + eps); }
                float hv[8]; const float cr = -1.4426950408889634f * r, iv = __builtin_amdgcn_rcpf(r * r);
#pragma unroll
                for (int n = 0; n < 2; ++n)
#pragma unroll
                    for (int e = 0; e < 4; ++e) { const float g = acc[ai][0][m][n][e], up = acc[ai][1][m][n][e];
                        hv[n * 4 + e] = (g * up) * __builtin_amdgcn_rcpf(__builtin_fmaf(__builtin_amdgcn_exp2f(cr * g), iv, iv)); }
                u32x4 w; w.x = cvt_pk_bf16(hv[0], hv[1]); w.y = cvt_pk_bf16(hv[2], hv[3]); w.z = cvt_pk_bf16(hv[4], hv[5]); w.w = cvt_pk_bf16(hv[6], hv[7]);
                __builtin_nontemporal_store(w, (u32x4*)(H + (((size_t)u.pm * (ldh / 64) + (col0 >> 6)) * 256 + (rl0 + ai * HALF + m * 16)) * 64 + (col0 & 63))); }
    }
};
struct EpiDown {
    static constexpr bool PERM = false, AFTER_DRAIN = false;
    const bf16_t* X1B; float* OUT; int ldc;
    __device__ __forceinline__ void operator()(const f32x4 (&acc)[2][2][4][2], const Unit& u, int wr, int wc, int fr, int fq) const {
        typedef unsigned u32x2 __attribute__((ext_vector_type(2)));
        const int row0 = u.pm * BM + wr * 64 + fr, col0 = u.pn * BM + wc * 32 + 4 * fq;
        u32x2 xv[2][4][2][2];
#pragma unroll
        for (int ai = 0; ai < 2; ++ai)
#pragma unroll
            for (int m = 0; m < 4; ++m)
#pragma unroll
                for (int bj = 0; bj < 2; ++bj)
#pragma unroll
                    for (int n = 0; n < 2; ++n) xv[ai][m][bj][n] = __builtin_nontemporal_load((const u32x2*)(X1B + (size_t)(row0 + ai * HALF + m * 16) * ldc + col0 + bj * HALF + n * 16));
        __builtin_amdgcn_sched_barrier(0);
#pragma unroll
        for (int ai = 0; ai < 2; ++ai)
#pragma unroll
            for (int m = 0; m < 4; ++m) { const size_t off = (size_t)(row0 + ai * HALF + m * 16) * ldc + col0;
#pragma unroll
                for (int bj = 0; bj < 2; ++bj)
#pragma unroll
                    for (int n = 0; n < 2; ++n) { const u32x2 w = xv[ai][m][bj][n];
                        const f32x4 a0 = {__builtin_bit_cast(float, w.x << 16), __builtin_bit_cast(float, w.x & 0xffff0000u), __builtin_bit_cast(float, w.y << 16), __builtin_bit_cast(float, w.y & 0xffff0000u)};
                        EPI_ST((f32x4*)(OUT + off + bj * HALF + n * 16), acc[ai][bj][m][n] + a0); } }
    }
};
template <class Epi, class Sched, bool ALIGN_EPI = false, bool SP2 = false, bool A_NT = false>
__device__ __forceinline__ void gemm_phase(PG8_LAS unsigned char* lds, const Gemm g, const Sched& S, const Epi& E) {
    const int tid = threadIdx.x, wid = __builtin_amdgcn_readfirstlane(tid >> 6), lane = tid & 63, wr = wid >> 2, wc = wid & 3, fr = lane & 15, fq = lane >> 4;
    const int K = g.K, nt = K / BK;
    const bool AT = g.a_tiled != 0;
    unsigned voffA[2], voffB[2];
#pragma unroll
    for (int i = 0; i < 2; ++i) { int R, C; stage_rc(tid * 16 + i * 8192, R, C); const int Rb = Epi::PERM ? ((R & ~31) + perm32(R & 31)) : R;
        voffA[i] = (unsigned)(R * (AT ? BK : K) + C) * 2u; voffB[i] = (unsigned)(Rb * K + C) * 2u; }
    const size_t kstepB = (size_t)(BK * 2), kstepA = AT ? (size_t)(BM * BK * 2) : kstepB;
    const size_t hstepB = (size_t)HALF * K * 2, hstepA = AT ? (size_t)(HALF * BK * 2) : hstepB;
    const size_t tstep = 2 * hstepB;
    const unsigned ldsw = (unsigned)wid * 1024u;
    const int aoff = lds_byte(wr * 64 + fr, fq * 8), boff = lds_byte(wc * 32 + fr, fq * 8);
#define PG8_SA(b, h) (((b) * 2 + (h)) * HTB)
#define PG8_SB(b, h) ((4 + (b) * 2 + (h)) * HTB)
#define PG8_STAGE_AUX(bufoff, gbase, voff, aux) do { _Pragma("unroll") for (int _i = 0; _i < 2; ++_i) \
        __builtin_amdgcn_global_load_lds((const unsigned*)((const char*)(gbase) + (voff)[_i]), (PG8_LAS unsigned*)(lds + (bufoff) + ldsw + _i * 8192), 16, 0, aux); } while (0)
#define PG8_STAGE(bufoff, gbase, voff) do { if constexpr (A_NT) { if ((bufoff) < 4 * HTB) PG8_STAGE_AUX(bufoff, gbase, voff, 2); else PG8_STAGE_AUX(bufoff, gbase, voff, 0); } else PG8_STAGE_AUX(bufoff, gbase, voff, 0); } while (0)
#define PG8_LDA(dst, b, h) do { _Pragma("unroll") for (int m = 0; m < 4; ++m) _Pragma("unroll") for (int k = 0; k < 2; ++k) dst[m][k] = *(const PG8_LAS bf16x8*)(lds + PG8_SA(b, h) + aoff + m * 2048 + k * 1024); } while (0)
#define PG8_LDB(dst, b, h) do { _Pragma("unroll") for (int n = 0; n < 2; ++n) _Pragma("unroll") for (int k = 0; k < 2; ++k) dst[n][k] = *(const PG8_LAS bf16x8*)(lds + PG8_SB(b, h) + boff + n * 2048 + k * 1024); } while (0)
#define PG8_MMA(ai, bj, At, Bt) do { __builtin_amdgcn_s_setprio(1); _Pragma("unroll") for (int m = 0; m < 4; ++m) _Pragma("unroll") for (int n = 0; n < 2; ++n) _Pragma("unroll") for (int k = 0; k < 2; ++k) \
        acc[ai][bj][m][n] = __builtin_amdgcn_mfma_f32_16x16x32_bf16(Bt[n][k], At[m][k], acc[ai][bj][m][n], 0, 0, 0); __builtin_amdgcn_s_setprio(0); } while (0)
#define PG8_WAIT_V(n) asm volatile("s_waitcnt vmcnt(" #n ")" ::: "memory")
#define PG8_WAIT_L(n) asm volatile("s_waitcnt lgkmcnt(" #n ")" ::: "memory")
#define PG8_BAR __builtin_amdgcn_s_barrier()
#define PG8_SCHED __builtin_amdgcn_sched_barrier(0)
    Unit cur, nxt; int ui = 0;
    if (!S.next(0, cur)) return;
    f32x4 acc[2][2][4][2];
#pragma unroll
    for (int a = 0; a < 2; ++a)
#pragma unroll
        for (int b = 0; b < 2; ++b)
#pragma unroll
            for (int m = 0; m < 4; ++m)
#pragma unroll
                for (int n = 0; n < 2; ++n) acc[a][b][m][n] = (f32x4){0.f, 0.f, 0.f, 0.f};
    bf16x8 At[4][2], B0[2][2], B1[2][2];
    const char* cA = (const char*)g.A + (size_t)cur.pm * tstep; const char* cB = (const char*)g.Bt + (size_t)cur.pn * tstep;
    S.a_ready(cur);
    if constexpr (SP2) {
        PG8_STAGE(PG8_SB(0, 0), cB, voffB); PG8_STAGE(PG8_SB(0, 1), cB + hstepB, voffB); PG8_STAGE(PG8_SA(0, 0), cA, voffA); PG8_STAGE(PG8_SA(0, 1), cA + hstepA, voffA);
        if (wr == 1) PG8_BAR;
        PG8_WAIT_V(2); PG8_BAR;
        PG8_STAGE(PG8_SB(1, 0), cB + kstepB, voffB); PG8_STAGE(PG8_SA(1, 0), cA + kstepA, voffA); PG8_STAGE(PG8_SB(1, 1), cB + hstepB + kstepB, voffB);
        PG8_WAIT_V(6); PG8_BAR;
    } else {
        PG8_STAGE(PG8_SB(0, 0), cB, voffB); PG8_STAGE(PG8_SA(0, 0), cA, voffA); PG8_STAGE(PG8_SB(0, 1), cB + hstepB, voffB); PG8_STAGE(PG8_SA(0, 1), cA + hstepA, voffA);
        if (wr == 1) PG8_BAR;
        PG8_WAIT_V(4); PG8_BAR;
        PG8_STAGE(PG8_SB(1, 0), cB + kstepB, voffB); PG8_STAGE(PG8_SA(1, 0), cA + kstepA, voffA); PG8_STAGE(PG8_SB(1, 1), cB + hstepB + kstepB, voffB);
        PG8_WAIT_V(6); PG8_BAR;
    }
    for (;;) {
        const bool has_next = S.next(ui + 1, nxt);
        const char* nA = has_next ? (const char*)g.A + (size_t)nxt.pm * tstep : cA; const char* nB = has_next ? (const char*)g.Bt + (size_t)nxt.pn * tstep : cB;
        for (int t = 0; t < nt; t += 2) {
            const bool last = (t == nt - 2);
            const char* a1 = cA + (size_t)(t + 1) * kstepA;
            const char* a2 = last ? nA : cA + (size_t)(t + 2) * kstepA; const char* b2 = last ? nB : cB + (size_t)(t + 2) * kstepB;
            const char* a3 = a2 + kstepA; const char* b3 = b2 + kstepB;
            if (last && has_next) S.a_ready(nxt);
            if constexpr (SP2) {
            PG8_LDB(B0, 0, 0); PG8_LDB(B1, 0, 1); PG8_SCHED; PG8_LDA(At, 0, 0); PG8_STAGE(PG8_SA(1, 1), a1 + hstepA, voffA);
            PG8_WAIT_V(8); PG8_WAIT_L(0); PG8_BAR; PG8_MMA(0, 0, At, B0); PG8_MMA(0, 1, At, B1); PG8_BAR; PG8_SCHED;
            PG8_LDA(At, 0, 1); PG8_STAGE(PG8_SB(0, 0), b2, voffB); PG8_STAGE(PG8_SB(0, 1), b2 + hstepB, voffB); PG8_STAGE(PG8_SA(0, 0), a2, voffA);
            PG8_WAIT_V(8); PG8_WAIT_L(0); PG8_BAR; PG8_MMA(1, 0, At, B0); PG8_MMA(1, 1, At, B1); PG8_BAR; PG8_SCHED;
            PG8_LDB(B0, 1, 0); PG8_LDB(B1, 1, 1); PG8_SCHED; PG8_LDA(At, 1, 0); PG8_STAGE(PG8_SA(0, 1), a2 + hstepA, voffA);
            PG8_WAIT_V(8); PG8_WAIT_L(0); PG8_BAR; PG8_MMA(0, 0, At, B0); PG8_MMA(0, 1, At, B1); PG8_BAR; PG8_SCHED;
            PG8_LDA(At, 1, 1); PG8_STAGE(PG8_SB(1, 0), b3, voffB); PG8_STAGE(PG8_SB(1, 1), b3 + hstepB, voffB); PG8_STAGE(PG8_SA(1, 0), a3, voffA);
            PG8_WAIT_V(8); PG8_WAIT_L(0); PG8_BAR; PG8_MMA(1, 0, At, B0); PG8_MMA(1, 1, At, B1); PG8_BAR; PG8_SCHED;
            } else {
            PG8_LDB(B0, 0, 0); PG8_SCHED; PG8_LDA(At, 0, 0); PG8_STAGE(PG8_SA(1, 1), a1 + hstepA, voffA);
            PG8_WAIT_L(8); PG8_BAR; PG8_WAIT_L(0); PG8_MMA(0, 0, At, B0); PG8_BAR; PG8_SCHED;
            PG8_LDB(B1, 0, 1); PG8_STAGE(PG8_SB(0, 0), b2, voffB);
            PG8_BAR; PG8_WAIT_L(0); PG8_MMA(0, 1, At, B1); PG8_BAR;
            PG8_LDA(At, 0, 1); PG8_STAGE(PG8_SA(0, 0), a2, voffA);
            PG8_BAR; PG8_WAIT_L(0); PG8_MMA(1, 0, At, B0); PG8_BAR; PG8_SCHED;
            PG8_STAGE(PG8_SB(0, 1), b2 + hstepB, voffB);
            PG8_WAIT_V(6); PG8_BAR; PG8_MMA(1, 1, At, B1); PG8_BAR;
            PG8_LDB(B0, 1, 0); PG8_SCHED; PG8_LDA(At, 1, 0); PG8_STAGE(PG8_SA(0, 1), a2 + hstepA, voffA);
            PG8_WAIT_L(8); PG8_BAR; PG8_WAIT_L(0); PG8_MMA(0, 0, At, B0); PG8_BAR; PG8_SCHED;
            PG8_LDB(B1, 1, 1); PG8_STAGE(PG8_SB(1, 0), b3, voffB);
            PG8_BAR; PG8_WAIT_L(0); PG8_MMA(0, 1, At, B1); PG8_BAR;
            PG8_LDA(At, 1, 1); PG8_STAGE(PG8_SA(1, 0), a3, voffA);
            PG8_BAR; PG8_WAIT_L(0); PG8_MMA(1, 0, At, B0); PG8_BAR; PG8_SCHED;
            PG8_STAGE(PG8_SB(1, 1), b3 + hstepB, voffB);
            PG8_WAIT_V(6); PG8_BAR; PG8_MMA(1, 1, At, B1); PG8_BAR;
            }
        }
        if constexpr (ALIGN_EPI) { if (wr == 0) PG8_BAR; }
        if constexpr (!Epi::AFTER_DRAIN) { E(acc, cur, wr, wc, fr, fq); S.done(cur); }
        if (!has_next) break;
#pragma unroll
        for (int a = 0; a < 2; ++a)
#pragma unroll
            for (int b = 0; b < 2; ++b)
#pragma unroll
                for (int m = 0; m < 4; ++m)
#pragma unroll
                    for (int n = 0; n < 2; ++n) acc[a][b][m][n] = (f32x4){0.f, 0.f, 0.f, 0.f};
        cur = nxt; cA = nA; cB = nB; ++ui;
        if constexpr (ALIGN_EPI) { if (wr == 1) PG8_BAR; }
    }
    PG8_WAIT_V(0);
    if constexpr (!ALIGN_EPI) { if (wr == 0) PG8_BAR; }
    PG8_BAR;
    if constexpr (Epi::AFTER_DRAIN) { E.fused(acc, cur, wr, wc, fr, fq, lds, wid, lane); S.done(cur); }
#undef PG8_SA
#undef PG8_SB
#undef PG8_STAGE
#undef PG8_STAGE_AUX
#undef PG8_LDA
#undef PG8_LDB
#undef PG8_MMA
#undef PG8_WAIT_V
#undef PG8_WAIT_L
#undef PG8_BAR
#undef PG8_SCHED
}
}
#ifndef PG8_SP2
#define PG8_SP2 true
#endif
#ifndef PG8_ALIGN
#define PG8_ALIGN true
#endif
#ifndef MK_N_LAUNCHES
#define MK_N_LAUNCHES 1
#endif
constexpr int NB = 16, SEQ = 2048, D = 1024, M = NB * SEQ;
constexpr int NMEM = 256, MM = NB * NMEM;
constexpr int NPROJ = 1792, DFF = 2816, NGU = 2 * DFF, NMKV = 512;
constexpr int C_Q = 0, C_K = 512, C_V = 640, C_CH = 768, C_CB = 1024, C_CC = 1280, C_QM = 1536;
constexpr float EPS = 1e-6f;
constexpr int NWAVES = 8, NPHASE = 6;
constexpr size_t MiB = 1u << 20;
constexpr size_t WS_SLOTS = 0;
constexpr size_t WS_WIN = 2 * MiB, WS_WMKV = 6 * MiB, WS_WOUT = 7 * MiB, WS_WGU = 9 * MiB, WS_WDN = 20 * MiB;
constexpr size_t WS_MEMN = 32 * MiB, WS_MEMKV = 40 * MiB, WS_X1B = 48 * MiB, WS_PROJ = 112 * MiB, WS_XN = 224 * MiB, WS_MERGED = WS_XN, WS_H = 112 * MiB, WS_END = 288 * MiB;
static_assert(WS_WIN + (size_t)NPROJ * D * 2 <= WS_WMKV && WS_WMKV + (size_t)NMKV * D * 2 <= WS_WOUT && WS_WOUT + (size_t)D * D * 2 <= WS_WGU && WS_WGU + (size_t)NGU * D * 2 <= WS_WDN && WS_WDN + (size_t)D * DFF * 2 <= WS_MEMN, "ws weights");
static_assert(WS_MEMN + (size_t)MM * D * 2 <= WS_MEMKV && WS_MEMKV + (size_t)MM * NMKV * 2 <= WS_X1B && WS_X1B + (size_t)M * D * 2 <= WS_PROJ && WS_PROJ + (size_t)M * NPROJ * 2 <= WS_XN && WS_XN + (size_t)M * D * 2 <= WS_END && WS_H + (size_t)M * DFF * 2 <= WS_END, "ws acts");
constexpr size_t WS_CTL = 26 * MiB, CTL_BYTES = 16384;
constexpr int LDS_BYTES = 147456;

#define LAS __attribute__((address_space(3)))
typedef unsigned short bf16;
typedef unsigned v4u __attribute__((ext_vector_type(4)));
typedef unsigned v2u __attribute__((ext_vector_type(2)));
typedef float f32x4 __attribute__((ext_vector_type(4)));
__device__ __forceinline__ unsigned f2bf(float f) { unsigned u = __builtin_bit_cast(unsigned, f); return (u + 0x7fffu + ((u >> 16) & 1u)) >> 16; }
__device__ __forceinline__ unsigned pk2(float lo, float hi) { return f2bf(lo) | (f2bf(hi) << 16); }
__device__ __forceinline__ float bf2f(bf16 v) { return __builtin_bit_cast(float, (unsigned)v << 16); }
__device__ __forceinline__ float bflo(unsigned w) { return __builtin_bit_cast(float, w << 16); }
__device__ __forceinline__ float bfhi(unsigned w) { return __builtin_bit_cast(float, w & 0xffff0000u); }
__device__ __forceinline__ float wave_sum(float v) {
#pragma unroll
    for (int o = 1; o < 64; o <<= 1) v += __shfl_xor(v, o);
    return v;
}
__device__ __forceinline__ float wave_max(float v) {
#pragma unroll
    for (int o = 1; o < 64; o <<= 1) v = fmaxf(v, __shfl_xor(v, o));
    return v;
}

#define XB_TMO      128
#define XB_XCNT(j)  (256  + 64 * (j))
#define XB_XSUB(j)  (1280 + 64 * (j))
#define XB_XGEN(j)  (2304 + 64 * (j))
#define XB_TOP      3328
#define XB_TOPGEN   3392
#define XCD_BAR_WORDS 3456
#define XB_SPIN_CAP (1u << 18)

__device__ __forceinline__ unsigned xb_ld(unsigned* p)              { return __hip_atomic_load(p, __ATOMIC_RELAXED, __HIP_MEMORY_SCOPE_AGENT); }
__device__ __forceinline__ unsigned xb_add(unsigned* p, unsigned v) { return __hip_atomic_fetch_add(p, v, __ATOMIC_RELAXED, __HIP_MEMORY_SCOPE_AGENT); }
__device__ __forceinline__ unsigned xb_xcc_id() { return (unsigned)__builtin_amdgcn_s_getreg((3 << 11) | 20) & 0xFu; }
#define XB_SPIN(cond, bar) do { unsigned _sp = 0; while (cond) { __builtin_amdgcn_s_sleep(1); \
    if ((++_sp & 255u) == 0u) { if (xb_ld(&(bar)[XB_TMO])) break; if (_sp > XB_SPIN_CAP) { atomicAdd(&(bar)[XB_TMO], 1u); break; } } } } while (0)

struct XcdBarrier {
    unsigned* bar; unsigned x;
    volatile LAS unsigned* st;
};

__device__ __forceinline__ XcdBarrier xcd_barrier_post(unsigned* bar, volatile LAS unsigned* st) {
    XcdBarrier b; b.bar = bar; b.x = xb_xcc_id(); b.st = st;
    if (threadIdx.x == 0) (void)xb_add(&bar[XB_XCNT(b.x)], 1u);
    return b;
}
__device__ __forceinline__ void xcd_barrier_complete(unsigned* bar, unsigned x, unsigned& nloc, unsigned& nx) {
    const unsigned G = gridDim.x * gridDim.y * gridDim.z;
    unsigned sum, cnt, mine, sp = 0u;
    for (;;) {
        sum = 0u; cnt = 0u; mine = 0u;
#pragma unroll
        for (unsigned j = 0; j < 16; ++j) { const unsigned c = xb_ld(&bar[XB_XCNT(j)]); sum += c; cnt += (c > 0u) ? 1u : 0u; mine = (j == x) ? c : mine; }
        if (sum == G) break;
        __builtin_amdgcn_s_sleep(1);
        if ((++sp & 255u) == 0u) { if (xb_ld(&bar[XB_TMO])) break; if (sp > XB_SPIN_CAP) { atomicAdd(&bar[XB_TMO], 1u); break; } }
    }
    nloc = mine > 0u ? mine : 1u; nx = cnt > 0u ? cnt : 1u;
}

__device__ __forceinline__ void xcd_barrier(const XcdBarrier& b) {
    asm volatile("s_waitcnt vmcnt(0)" ::: "memory");
    __syncthreads();
    if (threadIdx.x == 0) {
        unsigned* bar = b.bar;
        __builtin_amdgcn_s_waitcnt(0);
        unsigned nloc = b.st[0], nx = b.st[1];
        if (nloc == 0u) { xcd_barrier_complete(bar, b.x, nloc, nx); b.st[0] = nloc; b.st[1] = nx; }
        const unsigned old = xb_add(&bar[XB_XSUB(b.x)], 1u);
        const unsigned gen = old / nloc;
        if (old + 1u == (gen + 1u) * nloc) {
            __builtin_amdgcn_fence(__ATOMIC_RELEASE, "agent");
            asm volatile("s_waitcnt vmcnt(0)" ::: "memory");
            const unsigned og = xb_add(&bar[XB_TOP], 1u);
            const unsigned tg = og / nx;
            if (og + 1u == (tg + 1u) * nx) xb_add(&bar[XB_TOPGEN], 1u);
            else XB_SPIN(xb_ld(&bar[XB_TOPGEN]) == tg, bar);
            __builtin_amdgcn_fence(__ATOMIC_ACQUIRE, "agent");
            xb_add(&bar[XB_XGEN(b.x)], 1u);
            asm volatile("s_waitcnt vmcnt(0)" ::: "memory");
        } else {
            XB_SPIN(xb_ld(&bar[XB_XGEN(b.x)]) == gen, bar);
            __builtin_amdgcn_fence(__ATOMIC_ACQUIRE, "agent");
            asm volatile("s_waitcnt vmcnt(0)" ::: "memory");
        }
    }
    __syncthreads();
}

struct Args { const float* in[21]; float* out; unsigned char* ws; int ph_lo, ph_hi; };
enum { I_X = 0, I_MEM, I_NORM_MIX, I_W_IN, I_Q_NORM, I_K_NORM, I_SINKS, I_CONV_W, I_CONV_B, I_NORM_MEM, I_W_MEM_KV, I_MEM_Q_NORM, I_MEM_K_NORM,
       I_ON_ATTN, I_ON_CONV, I_ON_MEM, I_W_OUT, I_NORM_FFN, I_W_GATE, I_W_UP, I_W_DOWN };

__device__ __forceinline__ void p0_transpose_item(const float* W, int K, int N, bf16* WT, int dst_row0, const float* kscale, LAS float* scr, int k0, int n0, int lane) {
    float v[32];
#pragma unroll
    for (int i = 0; i < 32; ++i) { const int kk = 2 * i + (lane >> 5); v[i] = __builtin_nontemporal_load(W + (size_t)(k0 + kk) * N + n0 + (lane & 31)); }
    if (kscale) {
#pragma unroll
        for (int i = 0; i < 32; ++i) v[i] *= kscale[k0 + 2 * i + (lane >> 5)]; }
#pragma unroll
    for (int i = 0; i < 32; ++i) { const int kk = 2 * i + (lane >> 5); scr[kk * 33 + (lane & 31)] = v[i]; }
    asm volatile("s_waitcnt lgkmcnt(0)" ::: "memory");
    const int c = lane & 7;
#pragma unroll
    for (int j = 0; j < 4; ++j) { const int n = (lane >> 3) + 8 * j; const LAS float* s = scr + (8 * c) * 33 + n;
        v4u o; o.x = pk2(s[0 * 33], s[1 * 33]); o.y = pk2(s[2 * 33], s[3 * 33]); o.z = pk2(s[4 * 33], s[5 * 33]); o.w = pk2(s[6 * 33], s[7 * 33]);
        *(v4u*)(WT + (size_t)(dst_row0 + n) * K + k0 + 8 * c) = o; }
    asm volatile("s_waitcnt lgkmcnt(0)" ::: "memory");
}
constexpr int I_IN = (D / 64) * (NPROJ / 32), I_MK = (D / 64) * (NMKV / 32), I_O = (D / 64) * (D / 32), I_G = (D / 64) * (DFF / 32), I_DN = (DFF / 64) * (D / 32);
constexpr int NITEMS_EARLY = I_IN + I_MK + I_O, NITEMS_LATE = 2 * I_G + I_DN;
__device__ __forceinline__ void p0_weight_item(const Args& a, int it, LAS float* scr, int lane) {
    unsigned char* ws = a.ws; int r = it;
    if (r < I_IN) { const int nb = NPROJ / 32; p0_transpose_item(a.in[I_W_IN], D, NPROJ, (bf16*)(ws + WS_WIN), 32 * (r % nb), nullptr, scr, 64 * (r / nb), 32 * (r % nb), lane); return; } r -= I_IN;
    if (r < I_MK) { const int nb = NMKV / 32; p0_transpose_item(a.in[I_W_MEM_KV], D, NMKV, (bf16*)(ws + WS_WMKV), 32 * (r % nb), nullptr, scr, 64 * (r / nb), 32 * (r % nb), lane); return; } r -= I_MK;
    if (r < I_O) { const int nb = D / 32; const int k0 = 64 * (r / nb);
        const float* ks = k0 < 512 ? a.in[I_ON_ATTN] : (k0 < 768 ? a.in[I_ON_CONV] - 512 : a.in[I_ON_MEM] - 768);
        p0_transpose_item(a.in[I_W_OUT], D, D, (bf16*)(ws + WS_WOUT), 32 * (r % nb), ks, scr, k0, 32 * (r % nb), lane); return; } r -= I_O;
    if (r < 2 * I_G) { const int up = r >= I_G; if (up) r -= I_G; const int nb = DFF / 32, n0 = 32 * (r % nb);
        p0_transpose_item(a.in[up ? I_W_UP : I_W_GATE], D, DFF, (bf16*)(ws + WS_WGU), (n0 / 128) * 256 + up * 128 + (n0 % 128), a.in[I_NORM_FFN], scr, 64 * (r / nb), n0, lane); return; } r -= 2 * I_G;
    { const int nb = D / 32; p0_transpose_item(a.in[I_W_DOWN], DFF, D, (bf16*)(ws + WS_WDN), 32 * (r % nb), nullptr, scr, 64 * (r / nb), 32 * (r % nb), lane); }
}
__device__ __forceinline__ void p0_rows3(const Args& a, const int (&mrow)[3], int lane) {
    f32x4 v[3][4]; const float* gp[3]; bf16* op[3];
#pragma unroll
    for (int r = 0; r < 3; ++r) { const int m = mrow[r]; const bool isx = m < M;
        const float* src = isx ? a.in[I_X] + (size_t)m * D : a.in[I_MEM] + (size_t)(m - M) * D;
        gp[r] = isx ? a.in[I_NORM_MIX] : a.in[I_NORM_MEM];
        op[r] = isx ? (bf16*)(a.ws + WS_XN) + (size_t)m * D : (bf16*)(a.ws + WS_MEMN) + (size_t)(m - M) * D;
#pragma unroll
        for (int j = 0; j < 4; ++j) v[r][j] = __builtin_nontemporal_load((const f32x4*)src + lane + 64 * j); }
#pragma unroll
    for (int r = 0; r < 3; ++r) { float s = 0.f;
#pragma unroll
        for (int j = 0; j < 4; ++j) s += (v[r][j].x * v[r][j].x + v[r][j].y * v[r][j].y) + (v[r][j].z * v[r][j].z + v[r][j].w * v[r][j].w);
        const float rstd = __builtin_amdgcn_rsqf(wave_sum(s) * (1.f / D) + EPS);
        unsigned long long* o8 = (unsigned long long*)op[r] + lane;
#pragma unroll
        for (int j = 0; j < 4; ++j) { const f32x4 g = ((const f32x4*)gp[r])[lane + 64 * j];
            o8[64 * j] = (unsigned long long)pk2(v[r][j].x * rstd * g.x, v[r][j].y * rstd * g.y) | ((unsigned long long)pk2(v[r][j].z * rstd * g.z, v[r][j].w * rstd * g.w) << 32); } }
}
__device__ __forceinline__ void p0_prologue(const Args& a, LAS unsigned char* lds, int wave, int lane, bool defer_late) {
    LAS float* scr = (LAS float*)(lds + wave * 16384);
    const int gw = blockIdx.x * NWAVES + wave, NGW = gridDim.x * NWAVES;
    const int nitems = defer_late ? NITEMS_EARLY : NITEMS_EARLY + NITEMS_LATE;
    for (int it = gw; it < nitems; it += NGW) p0_weight_item(a, it, scr, lane);
    static_assert((M + MM) % 3 == 0, "rows in threes");
    if (gridDim.x == 256) {
        const int xcd = blockIdx.x & 7, lw = (blockIdx.x >> 3) * NWAVES + wave;
        for (int t = lw; t < 1536; t += 256) { int mr[3];
#pragma unroll
            for (int r = 0; r < 3; ++r) { const int vr = 3 * t + r; mr[r] = vr < 4096 ? 4096 * xcd + vr : M + 512 * xcd + (vr - 4096); }
            p0_rows3(a, mr, lane); }
    } else {
        for (int m0 = 3 * gw; m0 < M + MM; m0 += 3 * NGW) { const int mr[3] = {m0, m0 + 1, m0 + 2}; p0_rows3(a, mr, lane); }
    }
}
__device__ __forceinline__ void p1_late_weights(const Args& a, LAS unsigned char* lds, int wave, int lane, int wi, int nw) {
    LAS float* scr = (LAS float*)(lds + wave * 16384);
    for (int it = wi * NWAVES + wave; it < NITEMS_LATE; it += nw * NWAVES) p0_weight_item(a, NITEMS_EARLY + it, scr, lane);
}
namespace mx {
typedef short bf16x8 __attribute__((ext_vector_type(8)));
typedef short s16x4 __attribute__((ext_vector_type(4)));
typedef float f32x16 __attribute__((ext_vector_type(16)));
constexpr int KIMG = 0, VIMG = 65536, SSQA = 131072, SSQM = SSQA + 8192;
constexpr float LOG2E = 1.4426950408889634f, NEG = -1e30f;
__device__ __forceinline__ unsigned off_b(unsigned row, unsigned ch) { return 256u * row + 16u * (ch ^ (((row & 3) << 2) | ((row >> 2) & 3))); }
__device__ __forceinline__ void lds_barrier() { asm volatile("s_waitcnt lgkmcnt(0)\n\ts_barrier" ::: "memory"); }
__device__ __forceinline__ int crow(int r, int hi) { return (r & 3) + 8 * (r >> 2) + 4 * hi; }
__device__ __forceinline__ unsigned cvtpk(float lo, float hi) { typedef float f32x2_t __attribute__((ext_vector_type(2))); typedef __bf16 bf16x2_t __attribute__((ext_vector_type(2)));
    const f32x2_t v = {lo, hi}; const bf16x2_t b = __builtin_convertvector(v, bf16x2_t); return __builtin_bit_cast(unsigned, b); }
__device__ __forceinline__ s16x4 vtr(unsigned addr, LAS unsigned char* lds) { typedef short v4i16_t __attribute__((ext_vector_type(4)));
    return __builtin_bit_cast(s16x4, __builtin_amdgcn_ds_read_tr16_b64_v4i16((LAS v4i16_t*)(lds + addr))); }

struct KVRegs { v4u k[8], v[8]; };
__device__ __forceinline__ void issue_kv(KVRegs& R, const bf16* base, long krow0_off, long vrow0_off, int stride, int first_valid, int tid) {
    const bf16* kp = base + krow0_off + (long)(tid >> 4) * stride + (tid & 15) * 8; const bf16* vp = base + vrow0_off + (long)(tid >> 4) * stride + (tid & 15) * 8;
#pragma unroll
    for (int i = 0; i < 8; ++i) { const int row = (tid >> 4) + 32 * i;
        if (row >= first_valid) { R.k[i] = *(const v4u*)(kp + (long)(32 * i) * stride); R.v[i] = *(const v4u*)(vp + (long)(32 * i) * stride); }
        else { R.k[i] = (v4u){0u, 0u, 0u, 0u}; R.v[i] = (v4u){0u, 0u, 0u, 0u}; } }
}
__device__ __forceinline__ void commit_kv(const KVRegs& R, const LAS float* gain  , LAS unsigned char* lds, int tid) {
    const int c7 = (tid & 7) * 8;
    const f32x4 g0 = *(const LAS f32x4*)(gain + c7), g1 = *(const LAS f32x4*)(gain + c7 + 4);
    LAS unsigned char* kdst = lds + KIMG + off_b(tid >> 4, tid & 15);
#pragma unroll
    for (int i = 0; i < 8; ++i) {
        const v4u k = R.k[i];
        float x[8] = {bflo(k.x), bfhi(k.x), bflo(k.y), bfhi(k.y), bflo(k.z), bfhi(k.z), bflo(k.w), bfhi(k.w)};
        float ss = 0.f;
#pragma unroll
        for (int e = 0; e < 8; ++e) ss += x[e] * x[e];
        ss += __shfl_xor(ss, 1); ss += __shfl_xor(ss, 2); ss += __shfl_xor(ss, 4);
        const float rstd = __builtin_amdgcn_rsqf(ss * (1.f / 64) + EPS);
        v4u o; o.x = cvtpk(x[0] * rstd * g0[0], x[1] * rstd * g0[1]); o.y = cvtpk(x[2] * rstd * g0[2], x[3] * rstd * g0[3]);
        o.z = cvtpk(x[4] * rstd * g1[0], x[5] * rstd * g1[1]); o.w = cvtpk(x[6] * rstd * g1[2], x[7] * rstd * g1[3]);
        *(LAS v4u*)(kdst + 8192 * i) = o;
        *(LAS v4u*)(kdst + (VIMG - KIMG) + 8192 * i) = R.v[i]; }
}
struct QRaw { v4u r[4]; };
__device__ __forceinline__ void load_q_raw(QRaw& Q, const bf16* qrow  , int hi) {
#pragma unroll
    for (int d0 = 0; d0 < 4; ++d0) Q.r[d0] = __builtin_nontemporal_load((const v4u*)(qrow + 16 * d0 + 8 * hi));
}
__device__ __forceinline__ void norm_q(bf16x8 (&qf)[4], const QRaw& Q, const LAS float* gain  , float qscale, int hi) {
    float x[4][8]; float ss = 0.f;
#pragma unroll
    for (int d0 = 0; d0 < 4; ++d0) { const v4u k = Q.r[d0];
        x[d0][0] = bflo(k.x); x[d0][1] = bfhi(k.x); x[d0][2] = bflo(k.y); x[d0][3] = bfhi(k.y); x[d0][4] = bflo(k.z); x[d0][5] = bfhi(k.z); x[d0][6] = bflo(k.w); x[d0][7] = bfhi(k.w);
#pragma unroll
        for (int e = 0; e < 8; ++e) ss += x[d0][e] * x[d0][e]; }
    ss += __shfl_xor(ss, 32);
    const float rs = __builtin_amdgcn_rsqf(ss * (1.f / 64) + EPS) * qscale;
#pragma unroll
    for (int d0 = 0; d0 < 4; ++d0) { const f32x4 g0 = *(const LAS f32x4*)(gain + 16 * d0 + 8 * hi), g1 = *(const LAS f32x4*)(gain + 16 * d0 + 8 * hi + 4);
        v4u o; o.x = cvtpk(x[d0][0] * rs * g0[0], x[d0][1] * rs * g0[1]); o.y = cvtpk(x[d0][2] * rs * g0[2], x[d0][3] * rs * g0[3]);
        o.z = cvtpk(x[d0][4] * rs * g1[0], x[d0][5] * rs * g1[1]); o.w = cvtpk(x[d0][6] * rs * g1[2], x[d0][7] * rs * g1[3]);
        qf[d0] = __builtin_bit_cast(bf16x8, o); }
}
struct TileAddr { unsigned kb[4], vb[2][2]; };
__device__ __forceinline__ TileAddr tile_addr(int kvsel, int lane) {
    TileAddr A; const unsigned r32 = lane & 31, hi = lane >> 5, blk = (lane >> 4) & 1, qq = (lane & 15) >> 2, p = lane & 3;
#pragma unroll
    for (int d0 = 0; d0 < 4; ++d0) A.kb[d0] = KIMG + off_b(r32, 8 * kvsel + 2 * d0 + hi);
#pragma unroll
    for (int db = 0; db < 2; ++db)
#pragma unroll
        for (int t8 = 0; t8 < 2; ++t8) A.vb[db][t8] = VIMG + off_b(4 * hi + qq + 8 * t8, 4 * (2 * kvsel + db) + 2 * blk + (p >> 1)) + 8 * (p & 1);
    return A;
}
template <int EDGE, int TOFF>
__device__ __forceinline__ void attn_tile(LAS unsigned char* lds, const TileAddr& A, const bf16x8 (&qf)[4], const f32x16& cinit, float ck, f32x16 (&o)[2], f32x16& lacc, int lane) {
    const int r32 = lane & 31, hi = lane >> 5;
    bf16x8 kf[4]; s16x4 vlo[2][2], vhh[2][2];
#pragma unroll
    for (int d0 = 0; d0 < 4; ++d0) kf[d0] = *(const LAS bf16x8*)(lds + A.kb[d0] + TOFF);
#pragma unroll
    for (int db = 0; db < 2; ++db)
#pragma unroll
        for (int ks = 0; ks < 2; ++ks) { vlo[db][ks] = vtr(A.vb[db][0] + (TOFF + 4096 * ks), lds); vhh[db][ks] = vtr(A.vb[db][1] + (TOFF + 4096 * ks), lds); }
    __builtin_amdgcn_sched_barrier(0);
    f32x16 s;
#pragma unroll
    for (int d0 = 0; d0 < 4; ++d0) { if (d0 == 0) s = __builtin_amdgcn_mfma_f32_32x32x16_bf16(kf[d0], qf[d0], cinit, 0, 0, 0); else s = __builtin_amdgcn_mfma_f32_32x32x16_bf16(kf[d0], qf[d0], s, 0, 0, 0); }
#pragma unroll
    for (int r = 0; r < 16; ++r) { float p = __builtin_amdgcn_exp2f(s[r] + ck);
        if (EDGE == 1) p = (crow(r, hi) > r32) ? p : 0.f;
        if (EDGE == 2) p = (crow(r, hi) <= r32) ? p : 0.f;
        s[r] = p; }
    bf16x8 pa[2];
#pragma unroll
    for (int ks = 0; ks < 2; ++ks) { v4u w; w.x = cvtpk(s[8 * ks], s[8 * ks + 1]); w.y = cvtpk(s[8 * ks + 2], s[8 * ks + 3]); w.z = cvtpk(s[8 * ks + 4], s[8 * ks + 5]); w.w = cvtpk(s[8 * ks + 6], s[8 * ks + 7]);
        pa[ks] = __builtin_bit_cast(bf16x8, w); }
    const bf16x8 ones = {(short)0x3F80, (short)0x3F80, (short)0x3F80, (short)0x3F80, (short)0x3F80, (short)0x3F80, (short)0x3F80, (short)0x3F80};
#pragma unroll
    for (int ks = 0; ks < 2; ++ks) lacc = __builtin_amdgcn_mfma_f32_32x32x16_bf16(ones, pa[ks], lacc, 0, 0, 0);
#pragma unroll
    for (int db = 0; db < 2; ++db)
#pragma unroll
        for (int ks = 0; ks < 2; ++ks) {
            const bf16x8 vf = __builtin_shufflevector(vlo[db][ks], vhh[db][ks], 0, 1, 2, 3, 4, 5, 6, 7);
            o[db] = __builtin_amdgcn_mfma_f32_32x32x16_bf16(vf, pa[ks], o[db], 0, 0, 0); }
}
__device__ __forceinline__ TileAddr tile_addr_add(const TileAddr& A, unsigned off) { TileAddr B;
#pragma unroll
    for (int d0 = 0; d0 < 4; ++d0) B.kb[d0] = A.kb[d0] + off;
#pragma unroll
    for (int db = 0; db < 2; ++db)
#pragma unroll
        for (int t8 = 0; t8 < 2; ++t8) B.vb[db][t8] = A.vb[db][t8] + off;
    return B; }
__device__ __forceinline__ void zero_o(f32x16 (&o)[2]) {
#pragma unroll
    for (int db = 0; db < 2; ++db)
#pragma unroll
        for (int r = 0; r < 16; ++r) o[db][r] = 0.f;
}
__device__ __forceinline__ void store_o(const f32x16 (&o)[2], float scale, bf16* orow  , int hi) {
    bf16* dst = orow + (hi ? 8 : 0);
#pragma unroll
    for (int db = 0; db < 2; ++db)
#pragma unroll
        for (int g = 0; g < 4; g += 2) {
            unsigned ax = cvtpk(o[db][4 * g] * scale, o[db][4 * g + 1] * scale), ay = cvtpk(o[db][4 * g + 2] * scale, o[db][4 * g + 3] * scale);
            unsigned bx = cvtpk(o[db][4 * g + 4] * scale, o[db][4 * g + 5] * scale), by = cvtpk(o[db][4 * g + 6] * scale, o[db][4 * g + 7] * scale);
            { auto r = __builtin_amdgcn_permlane32_swap(ax, bx, false, false); ax = r[0]; bx = r[1]; }
            { auto r = __builtin_amdgcn_permlane32_swap(ay, by, false, false); ay = r[0]; by = r[1]; }
            *(v4u*)(dst + 32 * db + 8 * g) = (v4u){ax, ay, bx, by}; }
}
__device__ __forceinline__ float sumsq_o(const f32x16 (&o)[2]) { float s = 0.f;
#pragma unroll
    for (int db = 0; db < 2; ++db)
#pragma unroll
        for (int r = 0; r < 16; ++r) s += o[db][r] * o[db][r];
    return s; }
}

__device__ __forceinline__ void mixer_fast(const Args& a, LAS unsigned char* lds, int wave, int lane) {
    using namespace mx;
    const int tid = threadIdx.x, r32 = lane & 31, hi = lane >> 5;
    const bf16* PROJ = (const bf16*)(a.ws + WS_PROJ); const bf16* MEMKV = (const bf16*)(a.ws + WS_MEMKV); bf16* MERGED = (bf16*)(a.ws + WS_MERGED);
    LAS float* ssqa = (LAS float*)(lds + SSQA);
    LAS float* ssqm = (LAS float*)(lds + SSQM);
    LAS float* gtab = (LAS float*)(lds + 143360);
    if (wave == 0) gtab[lane] = a.in[I_Q_NORM][lane];
    if (wave == 1) gtab[64 + lane] = a.in[I_K_NORM][lane];
    if (wave == 2) gtab[128 + lane] = a.in[I_MEM_Q_NORM][lane];
    if (wave == 3) gtab[192 + lane] = a.in[I_MEM_K_NORM][lane];
    __syncthreads();
    const float refa = 8.16f * LOG2E * wave_max(fabsf(gtab[lane])) * wave_max(fabsf(gtab[64 + lane]));
    const float refm = 8.16f * LOG2E * wave_max(fabsf(gtab[128 + lane])) * wave_max(fabsf(gtab[192 + lane]));
    const int h = wave, kvsel_a = h >> 2; const float slope2 = exp2f(-(float)(h + 1)) * LOG2E, sink2 = a.in[I_SINKS][h] * LOG2E;
    const float mfix = fmaxf(refa, sink2);
    f32x16 cbias;
#pragma unroll
    for (int r = 0; r < 16; ++r) { cbias[r] = -slope2 * (float)(128 + r32 - crow(r, hi)) - mfix; }
    for (int u0 = blockIdx.x; u0 < NB * (SEQ / 128); u0 += gridDim.x) {
        const int u = (gridDim.x == 256) ? (u0 & 7) * 32 + (u0 >> 3) : u0;
        const int b = u / (SEQ / 128), n = u % (SEQ / 128); const long tok0 = (long)b * SEQ + n * 128;
        KVRegs R;
        lds_barrier();
        issue_kv(R, PROJ, (tok0 - 128) * NPROJ + C_K, (tok0 - 128) * NPROJ + C_V, NPROJ, n > 0 ? 0 : 128, tid);
        commit_kv(R, gtab + 64, lds, tid);
        int r32a = r32; asm volatile("" : "+v"(r32a));
        QRaw QR; load_q_raw(QR, PROJ + (tok0 + r32a) * NPROJ + C_Q + h * 64, hi);
        lds_barrier();
        {
            const bool has_prev = n > 0; int lane_a = lane; asm volatile("" : "+v"(lane_a)); const TileAddr TA = tile_addr(kvsel_a, lane_a);
#pragma unroll 1
            for (int j = 0; j < 4; ++j) {
                bf16x8 qf[4]; norm_q(qf, QR, gtab, 0.125f * LOG2E, hi);
                if (j < 3) load_q_raw(QR, PROJ + (tok0 + 32 * (j + 1) + r32a) * NPROJ + C_Q + h * 64, hi);
                else load_q_raw(QR, PROJ + (tok0 + 32 * (wave >> 1) + r32a) * NPROJ + C_QM + (wave & 1) * 64, hi);
                f32x16 o[2]; zero_o(o); f32x16 lacc;
#pragma unroll
                for (int r = 0; r < 16; ++r) lacc[r] = 0.f;
                const TileAddr TJ = tile_addr_add(TA, 8192u * j);
                if (has_prev || j >= 4) attn_tile<1, 0>(lds, TJ, qf, cbias, 0.f, o, lacc, lane);
                if (has_prev || j >= 3) attn_tile<0, 8192>(lds, TJ, qf, cbias, 32.f * slope2, o, lacc, lane);
                if (has_prev || j >= 2) attn_tile<0, 16384>(lds, TJ, qf, cbias, 64.f * slope2, o, lacc, lane);
                if (has_prev || j >= 1) attn_tile<0, 24576>(lds, TJ, qf, cbias, 96.f * slope2, o, lacc, lane);
                attn_tile<2, 32768>(lds, TJ, qf, cbias, 128.f * slope2, o, lacc, lane);
                const float inv = __builtin_amdgcn_rcpf(lacc[0] + __builtin_amdgcn_exp2f(sink2 - mfix));
#pragma unroll
                for (int db = 0; db < 2; ++db)
#pragma unroll
                    for (int r = 0; r < 16; ++r) o[db][r] *= inv;
                float ss = sumsq_o(o); ss += __shfl_xor(ss, 32);
                if (hi == 0) ssqa[((j & 1) * 128 + 32 * j + r32) * 8 + h] = ss;
                lds_barrier();
                const LAS f32x4* sp = (const LAS f32x4*)(ssqa + ((j & 1) * 128 + 32 * j + r32) * 8); const f32x4 s0 = sp[0], s1 = sp[1];
                const float tot = ((s0[0] + s0[1]) + (s0[2] + s0[3])) + ((s1[0] + s1[1]) + (s1[2] + s1[3]));
                store_o(o, __builtin_amdgcn_rsqf(tot * (1.f / 512) + EPS), MERGED + (tok0 + 32 * j + r32a) * D + h * 64, hi);
            }
        }
        {
            int lane_m = lane; asm volatile("" : "+v"(lane_m));
            const int hs = wave & 1, jq = wave >> 1; const TileAddr TA = tile_addr(hs, lane_m);
            f32x16 om[2][2]; f32x16 cneg;
#pragma unroll
            for (int r = 0; r < 16; ++r) cneg[r] = -refm;
#pragma unroll
            for (int pass = 0; pass < 2; ++pass) {
                lds_barrier();
                issue_kv(R, MEMKV, (long)b * NMEM * NMKV + 128 * pass, (long)b * NMEM * NMKV + 256 + 128 * pass, NMKV, 0, tid);
                commit_kv(R, gtab + 192, lds, tid);
                lds_barrier();
                const int hm = 2 * pass + hs;
                bf16x8 qf[4]; norm_q(qf, QR, gtab + 128, 0.125f * LOG2E, hi);
                if (pass == 0) load_q_raw(QR, PROJ + (tok0 + 32 * jq + r32) * NPROJ + C_QM + (2 + hs) * 64, hi);
                zero_o(om[pass]); f32x16 lacc;
#pragma unroll
                for (int r = 0; r < 16; ++r) lacc[r] = 0.f;
                attn_tile<0, 0>(lds, TA, qf, cneg, 0.f, om[pass], lacc, lane);     attn_tile<0, 8192>(lds, TA, qf, cneg, 0.f, om[pass], lacc, lane);
                attn_tile<0, 16384>(lds, TA, qf, cneg, 0.f, om[pass], lacc, lane); attn_tile<0, 24576>(lds, TA, qf, cneg, 0.f, om[pass], lacc, lane);
                attn_tile<0, 32768>(lds, TA, qf, cneg, 0.f, om[pass], lacc, lane); attn_tile<0, 40960>(lds, TA, qf, cneg, 0.f, om[pass], lacc, lane);
                attn_tile<0, 49152>(lds, TA, qf, cneg, 0.f, om[pass], lacc, lane); attn_tile<0, 57344>(lds, TA, qf, cneg, 0.f, om[pass], lacc, lane);
                const float inv = __builtin_amdgcn_rcpf(lacc[0]);
#pragma unroll
                for (int db = 0; db < 2; ++db)
#pragma unroll
                    for (int r = 0; r < 16; ++r) om[pass][db][r] *= inv;
            }
            float ss = sumsq_o(om[0]) + sumsq_o(om[1]); ss += __shfl_xor(ss, 32);
            if (hi == 0) ssqm[(32 * jq + r32) * 2 + hs] = ss;
            lds_barrier();
            const float tot = ssqm[(32 * jq + r32) * 2] + ssqm[(32 * jq + r32) * 2 + 1];
            const float rstd = __builtin_amdgcn_rsqf(tot * (1.f / 256) + EPS);
#pragma unroll
            for (int pass = 0; pass < 2; ++pass) { const int hm = 2 * pass + hs;
                store_o(om[pass], rstd, MERGED + (tok0 + 32 * jq + r32) * D + 768 + hm * 64, hi); }
        }
        {
            int tid_c = tid; asm volatile("" : "+v"(tid_c));
            const int c8 = (tid_c & 31) * 8, tg = tid_c >> 5;
            float w0[8], w1[8], w2[8], cb[8];
            const float* cw = a.in[I_CONV_W];
#pragma unroll
            for (int e = 0; e < 8; ++e) { w0[e] = cw[c8 + e]; w1[e] = cw[256 + c8 + e]; w2[e] = cw[512 + c8 + e]; cb[e] = a.in[I_CONV_B][c8 + e]; }
            float um2[8], um1[8];
            const int tseq0 = n * 128 + 8 * tg;
#pragma unroll
            for (int k = 0; k < 2; ++k) { float (&dst)[8] = k == 0 ? um2 : um1;
                if (tseq0 - 2 + k >= 0) { const bf16* r = PROJ + (tok0 + 8 * tg - 2 + k) * NPROJ; const v4u hh = __builtin_nontemporal_load((const v4u*)(r + C_CH + c8)), cc = __builtin_nontemporal_load((const v4u*)(r + C_CC + c8));
                    dst[0] = bflo(hh.x) * bflo(cc.x); dst[1] = bfhi(hh.x) * bfhi(cc.x); dst[2] = bflo(hh.y) * bflo(cc.y); dst[3] = bfhi(hh.y) * bfhi(cc.y);
                    dst[4] = bflo(hh.z) * bflo(cc.z); dst[5] = bfhi(hh.z) * bfhi(cc.z); dst[6] = bflo(hh.w) * bflo(cc.w); dst[7] = bfhi(hh.w) * bfhi(cc.w); }
                else {
#pragma unroll
                    for (int e = 0; e < 8; ++e) dst[e] = 0.f; } }
#pragma unroll
            for (int i0 = 0; i0 < 8; i0 += 4) {
                v4u hh4[4], cc4[4], bb4[4];
#pragma unroll
                for (int i = 0; i < 4; ++i) { const bf16* r = PROJ + (tok0 + 8 * tg + i0 + i) * NPROJ; hh4[i] = __builtin_nontemporal_load((const v4u*)(r + C_CH + c8)); cc4[i] = __builtin_nontemporal_load((const v4u*)(r + C_CC + c8)); bb4[i] = __builtin_nontemporal_load((const v4u*)(r + C_CB + c8)); }
#pragma unroll
                for (int i = 0; i < 4; ++i) { const long tok = tok0 + 8 * tg + i0 + i; const v4u hh = hh4[i], cc = cc4[i], bb = bb4[i];
                    float uc[8] = {bflo(hh.x) * bflo(cc.x), bfhi(hh.x) * bfhi(cc.x), bflo(hh.y) * bflo(cc.y), bfhi(hh.y) * bfhi(cc.y), bflo(hh.z) * bflo(cc.z), bfhi(hh.z) * bfhi(cc.z), bflo(hh.w) * bflo(cc.w), bfhi(hh.w) * bfhi(cc.w)};
                    const float bg[8] = {bflo(bb.x), bfhi(bb.x), bflo(bb.y), bfhi(bb.y), bflo(bb.z), bfhi(bb.z), bflo(bb.w), bfhi(bb.w)};
                    float ov[8], ss = 0.f;
#pragma unroll
                    for (int e = 0; e < 8; ++e) { ov[e] = bg[e] * (w0[e] * um2[e] + w1[e] * um1[e] + w2[e] * uc[e] + cb[e]); ss += ov[e] * ov[e]; um2[e] = um1[e]; um1[e] = uc[e]; }
                    ss += __shfl_xor(ss, 1); ss += __shfl_xor(ss, 2); ss += __shfl_xor(ss, 4); ss += __shfl_xor(ss, 8); ss += __shfl_xor(ss, 16);
                    const float rstd = __builtin_amdgcn_rsqf(ss * (1.f / 256) + EPS);
                    v4u w; w.x = cvtpk(ov[0] * rstd, ov[1] * rstd); w.y = cvtpk(ov[2] * rstd, ov[3] * rstd); w.z = cvtpk(ov[4] * rstd, ov[5] * rstd); w.w = cvtpk(ov[6] * rstd, ov[7] * rstd);
                    *(v4u*)(MERGED + tok * D + 512 + c8) = w; }
            }
        }
    }
}
__global__ void __launch_bounds__(NWAVES * 64, 2) fwd_megakernel(Args args) {
    extern __shared__ __attribute__((aligned(16))) unsigned char lds_raw[];
    LAS unsigned char* lds = (LAS unsigned char*)lds_raw;
    cg::grid_group grid = cg::this_grid();
    const int tid = threadIdx.x, lane = tid & 63, wave = __builtin_amdgcn_readfirstlane(tid >> 6);
    const int lo = args.ph_lo, hi = args.ph_hi, G = gridDim.x;
    unsigned char* ws = args.ws;
    volatile LAS unsigned* MISC = (volatile LAS unsigned*)(lds + LDS_BYTES - 256);
    if (tid < 64) MISC[tid] = 0u;
    __syncthreads();
    XcdBarrier bar; bar.bar = (unsigned*)(ws + WS_CTL); bar.x = 0; bar.st = nullptr;
    if (hi - lo > 1) bar = xcd_barrier_post((unsigned*)(ws + WS_CTL), MISC + 8);
    if (hi < 0) grid.sync();
#define IN(k) (lo <= (k) && (k) < hi)
#define SEAM(k) do { if (IN(k) && IN((k) + 1)) xcd_barrier(bar); } while (0)
    const bool defer_late = (G == 256) && (hi - lo > 1);
    if (IN(0)) { p0_prologue(args, lds, wave, lane, defer_late); }
    SEAM(0);
    if (IN(1)) {
        { pg8::Gemm g{(const bf16*)(ws + WS_XN), (const bf16*)(ws + WS_WIN), M, NPROJ, D, 0}; pg8::StaticOrder S; S.init(M, NPROJ, G, (int)blockIdx.x);
          pg8::EpiStoreBf16 E{(bf16*)(ws + WS_PROJ), NPROJ};
          pg8::gemm_phase<pg8::EpiStoreBf16, pg8::StaticOrder, PG8_ALIGN, PG8_SP2>(lds, g, S, E); }
        { pg8::Gemm g{(const bf16*)(ws + WS_MEMN), (const bf16*)(ws + WS_WMKV), MM, NMKV, D, 0}; pg8::StaticOrder S; S.init(MM, NMKV, G, (int)((blockIdx.x + G / 2) % G));
          pg8::EpiStoreBf16 E{(bf16*)(ws + WS_MEMKV), NMKV};
          pg8::gemm_phase<pg8::EpiStoreBf16, pg8::StaticOrder, PG8_ALIGN, PG8_SP2>(lds, g, S, E); }
        if (defer_late && blockIdx.x >= 160) { __syncthreads(); p1_late_weights(args, lds, wave, lane, (int)blockIdx.x - 160, 96); }
    }
    SEAM(1);
    if (IN(2)) { MIXER(args, lds, wave, lane); }
    SEAM(2);
    if (IN(3)) {
        pg8::Gemm g{(const bf16*)(ws + WS_MERGED), (const bf16*)(ws + WS_WOUT), M, D, D, 0}; pg8::StaticOrder S; S.init(M, D, G, (int)blockIdx.x);
        pg8::EpiOutProj E{args.in[I_X], (bf16*)(ws + WS_X1B), (float*)(ws + WS_SLOTS), D};
        pg8::gemm_phase<pg8::EpiOutProj, pg8::StaticOrder, PG8_ALIGN, PG8_SP2>(lds, g, S, E);
    }
    SEAM(3);
    if (IN(4)) {
        pg8::Gemm g{(const bf16*)(ws + WS_X1B), (const bf16*)(ws + WS_WGU), M, NGU, D, 0}; pg8::StaticOrder S; S.init(M, NGU, G, (int)blockIdx.x);
        LAS float* rtab = (LAS float*)(lds + 131072); int tpm[4] = {-1, -1, -1, -1}; int np = 0; bool tab_ok = true;
        { pg8::Unit uu; for (int i = 0; S.next(i, uu); ++i) { if (uu.pm == tpm[0] || uu.pm == tpm[1] || uu.pm == tpm[2] || uu.pm == tpm[3]) continue;
              if (np == 0) tpm[0] = uu.pm; else if (np == 1) tpm[1] = uu.pm; else if (np == 2) tpm[2] = uu.pm; else if (np == 3) tpm[3] = uu.pm; else tab_ok = false; ++np; } }
        if (tab_ok) {
#pragma unroll
            for (int p = 0; p < 4; ++p) if (p < np) { const int row = tid >> 1, half = tid & 1;
                const f32x4* sp = (const f32x4*)((const float*)(ws + WS_SLOTS) + ((size_t)tpm[p] * 256 + row) * 16 + half * 8); const f32x4 s0 = sp[0], s1 = sp[1];
                float ssum = ((s0[0] + s0[1]) + (s0[2] + s0[3])) + ((s1[0] + s1[1]) + (s1[2] + s1[3])); ssum += __shfl_xor(ssum, 1);
                if (half == 0) rtab[p * 256 + row] = __builtin_amdgcn_rsqf(ssum * (1.f / D) + EPS); }
            __syncthreads();
        }
        pg8::EpiSwiGLU E{(bf16*)(ws + WS_H), DFF, (const float*)(ws + WS_SLOTS), 1.f / D, EPS, rtab, tpm[0], tpm[1], tpm[2], tpm[3], tab_ok};
        pg8::gemm_phase<pg8::EpiSwiGLU, pg8::StaticOrder, PG8_ALIGN, PG8_SP2>(lds, g, S, E);
    }
    SEAM(4);
    if (IN(5)) {
        pg8::Gemm g{(const bf16*)(ws + WS_H), (const bf16*)(ws + WS_WDN), M, D, DFF, 1}; pg8::RevOrder S; S.init(M, D, G, (int)blockIdx.x);
        pg8::EpiDown E{(const bf16*)(ws + WS_X1B), args.out, D};
        pg8::gemm_phase<pg8::EpiDown, pg8::RevOrder, PG8_ALIGN, PG8_SP2>(lds, g, S, E);
    }
#undef IN
#undef SEAM
}

extern "C" void kernel_launch(void* const* d_in, const int* in_sizes, int n_in, void* d_out, int out_size, void* d_ws, size_t ws_size, hipStream_t stream) {
    static int grid = 0;
    if (grid == 0) {
        if (n_in != 21 || in_sizes[0] != M * D || out_size != M * D || ws_size < WS_END) { fprintf(stderr, "kernel_launch: unexpected shapes (n_in %d, in0 %d, out %d, ws %zu); nothing launched\n", n_in, n_in > 0 ? in_sizes[0] : -1, out_size, ws_size); grid = -1; return; }
        int dev = 0, cus = 0, per_cu = 0;
        if (hipGetDevice(&dev) != hipSuccess || hipDeviceGetAttribute(&cus, hipDeviceAttributeMultiprocessorCount, dev) != hipSuccess) { grid = -1; return; }
        if (hipFuncSetAttribute((const void*)fwd_megakernel, hipFuncAttributeMaxDynamicSharedMemorySize, LDS_BYTES) != hipSuccess) { fprintf(stderr, "kernel_launch: hipFuncSetAttribute failed\n"); grid = -1; return; }
        if (hipOccupancyMaxActiveBlocksPerMultiprocessor(&per_cu, (const void*)fwd_megakernel, NWAVES * 64, LDS_BYTES) != hipSuccess || per_cu < 1) { fprintf(stderr, "kernel_launch: occupancy query says %d\n", per_cu); per_cu = 1; }
        (void)hipGetLastError();
        grid = cus * (per_cu > 1 ? 1 : per_cu);
    }
    if (grid < 0) return;
    if (hipMemsetAsync((unsigned char*)d_ws + WS_CTL, 0, CTL_BYTES, stream) != hipSuccess) { fprintf(stderr, "kernel_launch: memset failed\n"); return; }
    Args a{};
    for (int i = 0; i < 21; ++i) a.in[i] = (const float*)d_in[i];
    a.out = (float*)d_out; a.ws = (unsigned char*)d_ws;
#if MK_N_LAUNCHES == 1
    a.ph_lo = 0; a.ph_hi = NPHASE;
    void* kargs[] = {&a};
    hipError_t e = hipLaunchCooperativeKernel((const void*)fwd_megakernel, dim3(grid), dim3(NWAVES * 64), kargs, LDS_BYTES, stream);
    if (e != hipSuccess) fprintf(stderr, "kernel_launch: cooperative launch failed: %s (grid %d)\n", hipGetErrorString(e), grid);
#else
    for (int p = 0; p < NPHASE; ++p) { a.ph_lo = p; a.ph_hi = p + 1;
        hipLaunchKernelGGL(fwd_megakernel, dim3(grid), dim3(NWAVES * 64), LDS_BYTES, stream, a); }
#endif
}
```
